# Optimizing an MI355X kernel written in HIP

```python
import jax, jax.numpy as jnp
from jax import lax
import numpy as np


D_MODEL = 1024
BATCH = 2
SEQ = 8192
DEPTH = 1

GRID_W = 64
CTX_LEN = 256
EPS = 1e-6

MLSTM_HEADS = 4
MLSTM_DH = 128
MLSTM_W = MLSTM_HEADS * MLSTM_DH
MLSTM_GATES = 2 * 2 * MLSTM_HEADS
MLSTM_CHUNK = 128

ATTN_Q_HEADS = 8
ATTN_KV_HEADS = 2
ATTN_GROUP = ATTN_Q_HEADS // ATTN_KV_HEADS
ATTN_DH = 64
ATTN_Q_W = ATTN_Q_HEADS * ATTN_DH
ATTN_KV_W = ATTN_KV_HEADS * ATTN_DH
WINDOW = 128
ATTN_BLOCK = 128
ROPE_BASE = 10000.0
ROPE_AXIS_FREQS = ATTN_DH // 4

N_BRANCH = 2
IN_SIZES = (MLSTM_W, MLSTM_W, MLSTM_W, MLSTM_W, MLSTM_GATES,
            ATTN_Q_W, ATTN_KV_W, ATTN_KV_W, N_BRANCH * D_MODEL)
D_IN = 4 * MLSTM_W + MLSTM_GATES + ATTN_Q_W + 2 * ATTN_KV_W + N_BRANCH * D_MODEL

PEER_HEADS = 8
PEER_N_KEYS = 128
PEER_N_EXPERTS = PEER_N_KEYS * PEER_N_KEYS
PEER_KEY_DIM = 256
PEER_HALF = PEER_KEY_DIM // 2
PEER_TOPK = 16
PEER_BLOCK = 128

kernel_name = 'hybrid_mlstm_swa_peer_dit_block'


def _rms(x, g):
    xf = x.astype(jnp.float32)
    y = xf * lax.rsqrt(jnp.mean(xf * xf, axis=-1, keepdims=True) + EPS)
    return y.astype(x.dtype) * g


def _modulate(x, g, shift, scale):
    return _rms(x, g) * (1 + scale) + shift


def _adaln(cond, w, b):
    mod = jax.nn.silu(cond) @ w + b
    return tuple(m[:, None, :] for m in jnp.split(mod, 6, axis=-1))


def _split_in(p):
    idx = []
    acc = 0
    for s in IN_SIZES[:-1]:
        acc += s
        idx.append(acc)
    return jnp.split(p, idx, axis=-1)


def _axial_rope(T):
    rows = T // GRID_W
    row = jnp.broadcast_to(jnp.arange(rows)[:, None], (rows, GRID_W)).reshape(T)
    col = jnp.broadcast_to(jnp.arange(GRID_W)[None, :], (rows, GRID_W)).reshape(T)
    inv = ROPE_BASE ** (-jnp.arange(ROPE_AXIS_FREQS, dtype=jnp.float32) / ROPE_AXIS_FREQS)
    ang = jnp.concatenate([row[:, None].astype(jnp.float32) * inv,
                           col[:, None].astype(jnp.float32) * inv], axis=-1)
    return jnp.cos(ang), jnp.sin(ang)


def _rope(t, cos, sin):
    t1, t2 = jnp.split(t, 2, axis=-1)
    c = cos[None, :, None, :]
    s = sin[None, :, None, :]
    return jnp.concatenate([t1 * c - t2 * s, t2 * c + t1 * s], axis=-1).astype(t.dtype)


def _chunk_seq(t, reverse):
    if reverse:
        t = jnp.flip(t, axis=1)
    B, T = t.shape[:2]
    t = jnp.moveaxis(t, 2, 1)
    return t.reshape((B, t.shape[1], T // MLSTM_CHUNK, MLSTM_CHUNK) + t.shape[3:])


def _unchunk(h, reverse):
    B, H = h.shape[:2]
    h = jnp.moveaxis(h.reshape(B, H, -1, h.shape[-1]), 1, 2)
    return jnp.flip(h, axis=1) if reverse else h


def _mlstm_summaries(k, v, li, lf):
    b = jnp.cumsum(lf, axis=-1)
    a = b[..., -1]
    w_log = a[..., None] - b + li
    m_loc = jnp.max(w_log, axis=-1)
    w = jnp.exp(w_log - m_loc[..., None])
    C_loc = jnp.einsum('bhcs,bhcsk,bhcsv->bhckv', w, k, v)
    n_loc = jnp.einsum('bhcs,bhcsk->bhck', w, k)
    return b, a, m_loc, C_loc, n_loc


def _mlstm_scan(a, m_loc, C_loc, n_loc, state0):
    def step(carry, inp):
        C, n, m = carry
        a_c, m_c, C_c, n_c = inp
        m_new = jnp.maximum(a_c + m, m_c)
        d_old = jnp.exp(a_c + m - m_new)
        d_new = jnp.exp(m_c - m_new)
        C_new = d_old[..., None, None] * C + d_new[..., None, None] * C_c
        n_new = d_old[..., None] * n + d_new[..., None] * n_c
        return (C_new, n_new, m_new), (C, n, m)
    xs = tuple(jnp.moveaxis(t, 2, 0) for t in (a, m_loc, C_loc, n_loc))
    final, starts = lax.scan(step, state0, xs)
    starts = tuple(jnp.moveaxis(t, 0, 2) for t in starts)
    return starts, final


def _mlstm_outputs(q, k, v, li, b, starts):
    C_s, n_s, m_s = starts
    L = q.shape[-2]
    log_inter = b + m_s[..., None]
    log_d = b[..., :, None] - b[..., None, :] + li[..., None, :]
    seen = jnp.tril(jnp.ones((L, L), dtype=bool))
    log_d = jnp.where(seen, log_d, -jnp.inf)
    m_t = jnp.maximum(log_inter, jnp.max(log_d, axis=-1))
    s = jnp.einsum('bhctk,bhcsk->bhcts', q, k) * jnp.exp(log_d - m_t[..., None])
    inter = jnp.exp(log_inter - m_t)
    num = (jnp.einsum('bhcts,bhcsv->bhctv', s, v)
           + inter[..., None] * jnp.einsum('bhctk,bhckv->bhctv', q, C_s))
    den = jnp.sum(s, axis=-1) + inter * jnp.einsum('bhctk,bhck->bhct', q, n_s)
    return num / jnp.maximum(jnp.abs(den), jnp.exp(-m_t))[..., None]


def _mlstm_direction(ctx_in, lat_in, reverse, with_ctx_out):
    qc, kc, vc, ic, fc = (_chunk_seq(t, reverse) for t in ctx_in)
    ql, kl, vl, il, fl = (_chunk_seq(t, reverse) for t in lat_in)
    B, H = qc.shape[:2]
    state0 = (jnp.zeros((B, H, MLSTM_DH, MLSTM_DH), jnp.float32),
              jnp.zeros((B, H, MLSTM_DH), jnp.float32),
              jnp.zeros((B, H), jnp.float32))
    bc, ac, mc, Cc, nc = _mlstm_summaries(kc, vc, ic, fc)
    starts_c, final_c = _mlstm_scan(ac, mc, Cc, nc, state0)
    bl, al, ml, Cl, nl = _mlstm_summaries(kl, vl, il, fl)
    starts_l, _ = _mlstm_scan(al, ml, Cl, nl, final_c)
    h_lat = _unchunk(_mlstm_outputs(ql, kl, vl, il, bl, starts_l), reverse)
    h_ctx = _unchunk(_mlstm_outputs(qc, kc, vc, ic, bc, starts_c), reverse) if with_ctx_out else None
    return h_lat, h_ctx


def _mlstm_branch(parts_lat, parts_ctx, b_mgates, norm_g, with_ctx_out):
    def prep(parts):
        q, k, v, o, gates = parts
        B, T = q.shape[:2]
        hd = lambda t: t.astype(jnp.float32).reshape(B, T, MLSTM_HEADS, MLSTM_DH)
        g = (gates.astype(jnp.float32) + b_mgates.astype(jnp.float32)).reshape(B, T, 2, 2, MLSTM_HEADS)
        return hd(q), hd(k) * (MLSTM_DH ** -0.5), hd(v), o, g

    ql, kl, vl, ol, gl = prep(parts_lat)
    qc, kc, vc, oc, gc = prep(parts_ctx)
    hs_lat, hs_ctx = [], []
    for d, reverse in enumerate((False, True)):
        lat_in = (ql, kl, vl, gl[:, :, d, 0], jax.nn.log_sigmoid(gl[:, :, d, 1]))
        ctx_in = (qc, kc, vc, gc[:, :, d, 0], jax.nn.log_sigmoid(gc[:, :, d, 1]))
        hl, hc = _mlstm_direction(ctx_in, lat_in, reverse, with_ctx_out)
        hs_lat.append(hl)
        hs_ctx.append(hc)

    def finish(h, o):
        B, T = h.shape[:2]
        hn = h * lax.rsqrt(jnp.mean(h * h, axis=-1, keepdims=True) + EPS)
        return hn.reshape(B, T, MLSTM_W).astype(o.dtype) * norm_g * jax.nn.sigmoid(o)

    m_lat = finish(hs_lat[0] + hs_lat[1], ol)
    m_ctx = finish(hs_ctx[0] + hs_ctx[1], oc) if with_ctx_out else None
    return m_lat, m_ctx


def _softmax_with_sink(logits, sink_b):
    sink_col = jnp.broadcast_to(sink_b, logits.shape[:-1] + (1,))
    return jax.nn.softmax(jnp.concatenate([logits, sink_col], axis=-1), axis=-1)[..., :-1]


def _window_attention(q, k, v, kc, vc, sink):
    B, T = q.shape[:2]
    nb = T // ATTN_BLOCK
    scale = ATTN_DH ** -0.5
    qb = q.reshape(B, nb, ATTN_BLOCK, ATTN_KV_HEADS, ATTN_GROUP, ATTN_DH)

    def band(t):
        tp = jnp.pad(t, ((0, 0), (ATTN_BLOCK, ATTN_BLOCK), (0, 0), (0, 0)))
        tp = tp.reshape(B, nb + 2, ATTN_BLOCK, ATTN_KV_HEADS, ATTN_DH)
        return jnp.concatenate([tp[:, :-2], tp[:, 1:-1], tp[:, 2:]], axis=2)

    kw, vw = band(k), band(v)
    qi = jnp.arange(ATTN_BLOCK)[:, None]
    kj = jnp.arange(3 * ATTN_BLOCK)[None, :]
    key_pos = jnp.arange(nb)[:, None, None] * ATTN_BLOCK - ATTN_BLOCK + kj[None]
    mask = (jnp.abs(kj - ATTN_BLOCK - qi) <= WINDOW)[None] & (key_pos >= 0) & (key_pos < T)
    s_loc = jnp.einsum('bnqhgd,bnkhd->bnhgqk', qb, kw).astype(jnp.float32) * scale
    s_loc = jnp.where(mask[None, :, None, None], s_loc, -jnp.inf)
    s_ctx = jnp.einsum('bnqhgd,bchd->bnhgqc', qb, kc).astype(jnp.float32) * scale
    sink_b = sink.astype(jnp.float32).reshape(ATTN_KV_HEADS, ATTN_GROUP, 1, 1)
    p = _softmax_with_sink(jnp.concatenate([s_loc, s_ctx], axis=-1), sink_b)
    p_loc = p[..., :3 * ATTN_BLOCK].astype(v.dtype)
    p_ctx = p[..., 3 * ATTN_BLOCK:].astype(v.dtype)
    out = (jnp.einsum('bnhgqk,bnkhd->bnqhgd', p_loc, vw)
           + jnp.einsum('bnhgqc,bchd->bnqhgd', p_ctx, vc))
    return out.reshape(B, T, ATTN_Q_W)


def _context_attention(qc, kc, vc, sink):
    B, Lc = qc.shape[:2]
    qg = qc.reshape(B, Lc, ATTN_KV_HEADS, ATTN_GROUP, ATTN_DH)
    s = jnp.einsum('bqhgd,bkhd->bhgqk', qg, kc).astype(jnp.float32) * (ATTN_DH ** -0.5)
    sink_b = sink.astype(jnp.float32).reshape(ATTN_KV_HEADS, ATTN_GROUP, 1, 1)
    p = _softmax_with_sink(s, sink_b).astype(vc.dtype)
    return jnp.einsum('bhgqk,bkhd->bqhgd', p, vc).reshape(B, Lc, ATTN_Q_W)


def _attn_branch(parts_lat, parts_ctx, q_g, k_g, sink, cos, sin, with_ctx_out):
    def heads(t, h):
        return t.reshape(t.shape[0], t.shape[1], h, ATTN_DH)
    ql, kl, vl = parts_lat
    qc, kc, vc = parts_ctx
    ql = _rope(_rms(heads(ql, ATTN_Q_HEADS), q_g), cos, sin)
    kl = _rope(_rms(heads(kl, ATTN_KV_HEADS), k_g), cos, sin)
    vl = heads(vl, ATTN_KV_HEADS)
    kc = _rms(heads(kc, ATTN_KV_HEADS), k_g)
    vc = heads(vc, ATTN_KV_HEADS)
    a_lat = _window_attention(ql, kl, vl, kc, vc, sink)
    a_ctx = None
    if with_ctx_out:
        a_ctx = _context_attention(_rms(heads(qc, ATTN_Q_HEADS), q_g), kc, vc, sink)
    return a_lat, a_ctx


def _token_mixer(h_lat, h_ctx, w_in, b_mgates, mlstm_norm_g, q_g, k_g, sink,
                 w_bm, w_ba, w_out, cos, sin, with_ctx_out):
    pl = _split_in(h_lat @ w_in)
    pc = _split_in(h_ctx @ w_in)
    m_lat, m_ctx = _mlstm_branch(pl[:5], pc[:5], b_mgates, mlstm_norm_g, with_ctx_out)
    a_lat, a_ctx = _attn_branch(pl[5:8], pc[5:8], q_g, k_g, sink, cos, sin, with_ctx_out)

    def merge(m, a, gates):
        g_m, g_a = jnp.split(gates, 2, axis=-1)
        return (jax.nn.sigmoid(g_m) * (m @ w_bm) + jax.nn.sigmoid(g_a) * (a @ w_ba)) @ w_out

    y_lat = merge(m_lat, a_lat, pl[8])
    y_ctx = merge(m_ctx, a_ctx, pc[8]) if with_ctx_out else None
    return y_lat, y_ctx


def _peer(h, w_query, sub_keys, expert_u, expert_v):
    B, T, D = h.shape
    tok = h.reshape(-1, PEER_BLOCK, D)

    def block(xb):
        q = (xb @ w_query).reshape(PEER_BLOCK, PEER_HEADS, 2, PEER_HALF)
        s = jnp.einsum('mhpd,hpnd->mhpn', q, sub_keys).astype(jnp.float32)
        s1, i1 = lax.top_k(s[:, :, 0], PEER_TOPK)
        s2, i2 = lax.top_k(s[:, :, 1], PEER_TOPK)
        cand = (s1[..., :, None] + s2[..., None, :]).reshape(PEER_BLOCK, PEER_HEADS, PEER_TOPK * PEER_TOPK)
        cidx = (i1[..., :, None] * PEER_N_KEYS + i2[..., None, :]).reshape(PEER_BLOCK, PEER_HEADS, PEER_TOPK * PEER_TOPK)
        top, pos = lax.top_k(cand, PEER_TOPK)
        idx = jnp.take_along_axis(cidx, pos, axis=-1)
        g = jax.nn.softmax(top, axis=-1)
        act = jax.nn.gelu(jnp.einsum('mhkd,md->mhk', expert_u[idx], xb).astype(jnp.float32))
        w = (g * act).astype(xb.dtype)
        return jnp.einsum('mhk,mhkd->md', w, expert_v[idx])

    return lax.map(block, tok).reshape(B, T, D)


def setup_inputs(seed: int = 0) -> dict:
    key = jax.random.key(seed)
    ks = jax.random.split(key, 24)
    f32 = jnp.float32

    def nrm(k, shape, s):
        return jax.random.normal(k, shape, f32) * s

    gate_base = jnp.tile(jnp.concatenate([jnp.zeros((MLSTM_HEADS,), f32),
                                          jnp.linspace(3.0, 6.0, MLSTM_HEADS, dtype=f32)]), 2)
    return {
        'x': nrm(ks[0], (BATCH, SEQ, D_MODEL), 1.0),
        'c': nrm(ks[1], (BATCH, D_MODEL), 1.0),
        'ctx': nrm(ks[2], (BATCH, CTX_LEN, D_MODEL), 1.0),
        'c_ctx': nrm(ks[3], (D_MODEL,), 1.0),
        'w_ada': nrm(ks[4], (DEPTH, D_MODEL, 6 * D_MODEL), D_MODEL ** -0.5),
        'b_ada': nrm(ks[5], (DEPTH, 6 * D_MODEL), 0.02),
        'norm_mix_g': 1.0 + nrm(ks[6], (DEPTH, D_MODEL), 0.02),
        'norm_ffn_g': 1.0 + nrm(ks[7], (DEPTH, D_MODEL), 0.02),
        'w_in': nrm(ks[8], (DEPTH, D_MODEL, D_IN), D_MODEL ** -0.5),
        'b_mgates': gate_base + nrm(ks[9], (DEPTH, MLSTM_GATES), 0.1),
        'mlstm_norm_g': 1.0 + nrm(ks[10], (DEPTH, MLSTM_W), 0.02),
        'attn_q_norm_g': 1.0 + nrm(ks[11], (DEPTH, ATTN_DH), 0.02),
        'attn_k_norm_g': 1.0 + nrm(ks[12], (DEPTH, ATTN_DH), 0.02),
        'attn_sink': nrm(ks[13], (DEPTH, ATTN_Q_HEADS), 0.5),
        'w_branch_m': nrm(ks[14], (DEPTH, MLSTM_W, D_MODEL), MLSTM_W ** -0.5),
        'w_branch_a': nrm(ks[15], (DEPTH, ATTN_Q_W, D_MODEL), ATTN_Q_W ** -0.5),
        'w_out': nrm(ks[16], (DEPTH, D_MODEL, D_MODEL), D_MODEL ** -0.5),
        'peer_w_query': nrm(ks[17], (DEPTH, D_MODEL, PEER_HEADS * PEER_KEY_DIM), D_MODEL ** -0.5),
        'peer_sub_keys': nrm(ks[18], (DEPTH, PEER_HEADS, 2, PEER_N_KEYS, PEER_HALF), PEER_HALF ** -0.5),
        'peer_u': nrm(ks[19], (DEPTH, PEER_N_EXPERTS, D_MODEL), D_MODEL ** -0.5),
        'peer_v': nrm(ks[20], (DEPTH, PEER_N_EXPERTS, D_MODEL), 0.5),
    }


def reference(x, c, ctx, c_ctx, w_ada, b_ada, norm_mix_g, norm_ffn_g, w_in, b_mgates,
              mlstm_norm_g, attn_q_norm_g, attn_k_norm_g, attn_sink, w_branch_m, w_branch_a,
              w_out, peer_w_query, peer_sub_keys, peer_u, peer_v):
    T = x.shape[1]
    cos, sin = _axial_rope(T)
    for layer in range(DEPTH):
        update_ctx = layer + 1 < DEPTH
        sh1, sc1, g1, sh2, sc2, g2 = _adaln(c, w_ada[layer], b_ada[layer])
        csh1, csc1, cg1, csh2, csc2, cg2 = _adaln(c_ctx[None], w_ada[layer], b_ada[layer])
        h_lat = _modulate(x, norm_mix_g[layer], sh1, sc1)
        h_ctx = _modulate(ctx, norm_mix_g[layer], csh1, csc1)
        y_lat, y_ctx = _token_mixer(h_lat, h_ctx, w_in[layer], b_mgates[layer], mlstm_norm_g[layer],
                                    attn_q_norm_g[layer], attn_k_norm_g[layer], attn_sink[layer],
                                    w_branch_m[layer], w_branch_a[layer], w_out[layer],
                                    cos, sin, update_ctx)
        x = x + g1 * y_lat
        x = x + g2 * _peer(_modulate(x, norm_ffn_g[layer], sh2, sc2), peer_w_query[layer],
                           peer_sub_keys[layer], peer_u[layer], peer_v[layer])
        if update_ctx:
            ctx = ctx + cg1 * y_ctx
            ctx = ctx + cg2 * _peer(_modulate(ctx, norm_ffn_g[layer], csh2, csc2), peer_w_query[layer],
                                    peer_sub_keys[layer], peer_u[layer], peer_v[layer])
    return x
```

```cpp
#include <hip/hip_runtime.h>
#include <cstdio>
#include <cstdint>
namespace pg8 {
#define PG8_LAS __attribute__((address_space(3)))
typedef unsigned short bf16_t;
typedef short bf16x8 __attribute__((ext_vector_type(8)));
typedef float f32x4 __attribute__((ext_vector_type(4)));
typedef unsigned u32x4 __attribute__((ext_vector_type(4)));
constexpr int BM = 256, BK = 64, HALF = 128, HTB = HALF * BK * 2  , STAGE_BYTES = 8 * HTB, NXCD = 8, WGM = 8;

__host__ __device__ __forceinline__ int lds_byte(int r, int c) { const int st = (r >> 4) * 2 + (c >> 5), rr = r & 15, cc = c & 31, ob = rr * 64 + cc * 2; return st * 1024 + (ob ^ (((ob >> 9) & 1) << 5)); }
__host__ __device__ __forceinline__ void stage_rc(int b, int& R, int& C) { const int st = b / 1024, sb = b % 1024, swz = sb ^ (((sb >> 9) & 1) << 5); R = (st >> 1) * 16 + swz / 64; C = (st & 1) * 32 + (swz % 64) / 2; }
__host__ __device__ __forceinline__ int perm32(int rho) { const int n = rho >> 4, i = rho & 15; return 8 * (i >> 2) + 4 * n + (i & 3); }

struct Unit { int pm, pn; };
struct Gemm { const bf16_t* A; const bf16_t* Bt; int M, N, K, lda, ldb; };

struct StaticOrder {
    int nM, nN, nwg, G, c;
    __host__ __device__ void init(int M, int N, int G_, int c_) { nM = M / BM; nN = N / BM; nwg = nM * nN; G = G_; c = c_; }
    __host__ __device__ bool next(int i, Unit& u) const {
        const long L = (long)i * G + c; if (L >= nwg) return false;
        int wgid = (int)L; { const int q = nwg / NXCD, r = nwg % NXCD, xcd = wgid % NXCD, off = wgid / NXCD; wgid = (xcd < r ? xcd * (q + 1) : r * (q + 1) + (xcd - r) * q) + off; }
        const int nig = WGM * nN, gid = wgid / nig, fm = gid * WGM, gsz = (nM - fm) < WGM ? (nM - fm) : WGM;
        u.pm = fm + ((wgid % nig) % gsz); u.pn = (wgid % nig) / gsz; return true;
    }
    __device__ __forceinline__ void a_ready(const Unit&) const {}
    __device__ __forceinline__ void done(const Unit&) const {}
};

__device__ __forceinline__ unsigned cvt_pk_bf16(float lo, float hi) { unsigned r; asm volatile("v_cvt_pk_bf16_f32 %0, %1, %2" : "=v"(r) : "v"(lo), "v"(hi)); return r; }
typedef float f32x2 __attribute__((ext_vector_type(2)));
__device__ __forceinline__ f32x2 gelu_pk(f32x2 v) {
    const f32x2 av = __builtin_elementwise_abs(v), d = av * 0.2316418882f + 1.0f;
    f32x2 t; t.x = __builtin_amdgcn_rcpf(d.x); t.y = __builtin_amdgcn_rcpf(d.y);
    f32x2 q = t * 0.5307027145f + (-0.7265760135f); q = q * t + 0.7107068705f; q = q * t + (-0.142248368f); q = q * t + 0.127414796f; q = q * t;
    const f32x2 s = (v * v) * (-0.72134752044f);
    f32x2 e; e.x = __builtin_amdgcn_exp2f(s.x); e.y = __builtin_amdgcn_exp2f(s.y);
    const f32x2 m = v * (q * e), r = v - m;
    f32x2 o; o.x = v.x < 0.f ? m.x : r.x; o.y = v.y < 0.f ? m.y : r.y; return o;
}

template <int ACT  > struct EpiBf16 {
    static constexpr bool PERM = true, AFTER_DRAIN = false; static_assert(ACT == 0 || ACT == 1, "EpiBf16: ACT is 0 (none) or 1 (gelu_pk)");
    bf16_t* O; int ldc; const float* bias; int split_cols; size_t split_stride; float scale0;
    __device__ __forceinline__ void operator()(const f32x4 (&acc)[2][2][4][2], const Unit& u, int wr, int wc, int fr, int fq) const {
        const int row0 = u.pm * BM + wr * 64 + fr; int colt = u.pn * BM; bf16_t* base = O;
        float sc = 1.f; if (split_cols) { const int t = colt / split_cols; base += (size_t)t * split_stride; colt -= t * split_cols; if (t == 0) sc = scale0; }
        const int col0 = colt + wc * 32 + 8 * fq, bcol0 = u.pn * BM + wc * 32 + 8 * fq;
        f32x4 bv[2][2];
#pragma unroll
        for (int bj = 0; bj < 2; ++bj)
#pragma unroll
            for (int n = 0; n < 2; ++n) bv[bj][n] = bias ? *(const f32x4*)(bias + bcol0 + bj * HALF + 4 * n) : (f32x4){0.f, 0.f, 0.f, 0.f};
#pragma unroll
        for (int ai = 0; ai < 2; ++ai)
#pragma unroll
            for (int m = 0; m < 4; ++m) { bf16_t* rowp = base + (size_t)(row0 + ai * HALF + m * 16) * ldc + col0;
#pragma unroll
                for (int bj = 0; bj < 2; ++bj) { f32x4 v0 = acc[ai][bj][m][0] + bv[bj][0], v1 = acc[ai][bj][m][1] + bv[bj][1];
                    if (ACT == 1) { f32x2 a = gelu_pk((f32x2){v0[0], v0[1]}), b = gelu_pk((f32x2){v0[2], v0[3]}), c = gelu_pk((f32x2){v1[0], v1[1]}), d = gelu_pk((f32x2){v1[2], v1[3]});
                        v0 = (f32x4){a.x, a.y, b.x, b.y}; v1 = (f32x4){c.x, c.y, d.x, d.y}; }
                    v0 = v0 * sc; v1 = v1 * sc; u32x4 w; w.x = cvt_pk_bf16(v0[0], v0[1]); w.y = cvt_pk_bf16(v0[2], v0[3]); w.z = cvt_pk_bf16(v1[0], v1[1]); w.w = cvt_pk_bf16(v1[2], v1[3]);
                    *(u32x4*)(rowp + bj * HALF) = w; } }
    }
};

template <class Epi, class Sched, bool ALIGN_EPI = false, bool SP2 = false>
__device__ __forceinline__ void gemm_phase(PG8_LAS unsigned char* lds, const Gemm g, const Sched& S, const Epi& E) {
    const int tid = threadIdx.x, wid = __builtin_amdgcn_readfirstlane(tid >> 6), lane = tid & 63, wr = wid >> 2, wc = wid & 3, fr = lane & 15, fq = lane >> 4;
    const int K = g.K, nt = K / BK;
    unsigned voffA[2], voffB[2];
#pragma unroll
    for (int i = 0; i < 2; ++i) { int R, C; stage_rc(tid * 16 + i * 8192, R, C); const int Rb = Epi::PERM ? ((R & ~31) + perm32(R & 31)) : R;
        voffA[i] = (unsigned)(R * g.lda + C) * 2u; voffB[i] = (unsigned)(Rb * g.ldb + C) * 2u; }
    const size_t kstep = (size_t)(BK * 2);
    const size_t hstepA = (size_t)HALF * g.lda * 2, hstepB = (size_t)HALF * g.ldb * 2;
    const size_t tstepA = 2 * hstepA, tstepB = 2 * hstepB;
    const unsigned ldsw = (unsigned)wid * 1024u;
    const int aoff = lds_byte(wr * 64 + fr, fq * 8), boff = lds_byte(wc * 32 + fr, fq * 8);
#define PG8_SA(b, h) (((b) * 2 + (h)) * HTB)
#define PG8_SB(b, h) ((4 + (b) * 2 + (h)) * HTB)
#define PG8_STAGE(bufoff, gbase, voff) do { _Pragma("unroll") for (int _i = 0; _i < 2; ++_i) \
        __builtin_amdgcn_global_load_lds((const unsigned*)((const char*)(gbase) + (voff)[_i]), (PG8_LAS unsigned*)(lds + (bufoff) + ldsw + _i * 8192), 16, 0, 0); } while (0)
#define PG8_LDA(dst, b, h) do { _Pragma("unroll") for (int m = 0; m < 4; ++m) _Pragma("unroll") for (int k = 0; k < 2; ++k) dst[m][k] = *(const PG8_LAS bf16x8*)(lds + PG8_SA(b, h) + aoff + m * 2048 + k * 1024); } while (0)
#define PG8_LDB(dst, b, h) do { _Pragma("unroll") for (int n = 0; n < 2; ++n) _Pragma("unroll") for (int k = 0; k < 2; ++k) dst[n][k] = *(const PG8_LAS bf16x8*)(lds + PG8_SB(b, h) + boff + n * 2048 + k * 1024); } while (0)
#define PG8_MMA(ai, bj, At, Bt) do { __builtin_amdgcn_s_setprio(1); _Pragma("unroll") for (int m = 0; m < 4; ++m) _Pragma("unroll") for (int n = 0; n < 2; ++n) _Pragma("unroll") for (int k = 0; k < 2; ++k) \
        acc[ai][bj][m][n] = __builtin_amdgcn_mfma_f32_16x16x32_bf16(Bt[n][k], At[m][k], acc[ai][bj][m][n], 0, 0, 0); __builtin_amdgcn_s_setprio(0); } while (0)
#define PG8_WAIT_V(n) asm volatile("s_waitcnt vmcnt(" #n ")" ::: "memory")
#define PG8_WAIT_L(n) asm volatile("s_waitcnt lgkmcnt(" #n ")" ::: "memory")
#define PG8_BAR __builtin_amdgcn_s_barrier()
#define PG8_SCHED __builtin_amdgcn_sched_barrier(0)
    Unit cur, nxt; int ui = 0;
    if (!S.next(0, cur)) return;
    f32x4 acc[2][2][4][2];
#pragma unroll
    for (int a = 0; a < 2; ++a)
#pragma unroll
        for (int b = 0; b < 2; ++b)
#pragma unroll
            for (int m = 0; m < 4; ++m)
#pragma unroll
                for (int n = 0; n < 2; ++n) acc[a][b][m][n] = (f32x4){0.f, 0.f, 0.f, 0.f};
    bf16x8 At[4][2], B0[2][2], B1[2][2];
    const char* cA = (const char*)g.A + (size_t)cur.pm * tstepA; const char* cB = (const char*)g.Bt + (size_t)cur.pn * tstepB;
    S.a_ready(cur);
    if constexpr (SP2) {
        PG8_STAGE(PG8_SB(0, 0), cB, voffB); PG8_STAGE(PG8_SB(0, 1), cB + hstepB, voffB); PG8_STAGE(PG8_SA(0, 0), cA, voffA); PG8_STAGE(PG8_SA(0, 1), cA + hstepA, voffA);
        if (wr == 1) PG8_BAR;
        PG8_WAIT_V(2); PG8_BAR;
        PG8_STAGE(PG8_SB(1, 0), cB + kstep, voffB); PG8_STAGE(PG8_SA(1, 0), cA + kstep, voffA); PG8_STAGE(PG8_SB(1, 1), cB + hstepB + kstep, voffB);
        PG8_WAIT_V(6); PG8_BAR;
    } else {
        PG8_STAGE(PG8_SB(0, 0), cB, voffB); PG8_STAGE(PG8_SA(0, 0), cA, voffA); PG8_STAGE(PG8_SB(0, 1), cB + hstepB, voffB); PG8_STAGE(PG8_SA(0, 1), cA + hstepA, voffA);
        if (wr == 1) PG8_BAR;
        PG8_WAIT_V(4); PG8_BAR;
        PG8_STAGE(PG8_SB(1, 0), cB + kstep, voffB); PG8_STAGE(PG8_SA(1, 0), cA + kstep, voffA); PG8_STAGE(PG8_SB(1, 1), cB + hstepB + kstep, voffB);
        PG8_WAIT_V(6); PG8_BAR;
    }
    for (;;) {
        const bool has_next = S.next(ui + 1, nxt);
        const char* nA = has_next ? (const char*)g.A + (size_t)nxt.pm * tstepA : cA; const char* nB = has_next ? (const char*)g.Bt + (size_t)nxt.pn * tstepB : cB;
        for (int t = 0; t < nt; t += 2) {
            const bool last = (t == nt - 2);
            const char* a1 = cA + (size_t)(t + 1) * kstep;
            const char* a2 = last ? nA : cA + (size_t)(t + 2) * kstep; const char* b2 = last ? nB : cB + (size_t)(t + 2) * kstep;
            const char* a3 = a2 + kstep; const char* b3 = b2 + kstep;
            if (last && has_next) S.a_ready(nxt);
            if constexpr (SP2) {
            PG8_LDB(B0, 0, 0); PG8_LDB(B1, 0, 1); PG8_SCHED; PG8_LDA(At, 0, 0); PG8_STAGE(PG8_SA(1, 1), a1 + hstepA, voffA);
            PG8_WAIT_V(8); PG8_WAIT_L(0); PG8_BAR; PG8_MMA(0, 0, At, B0); PG8_MMA(0, 1, At, B1); PG8_BAR; PG8_SCHED;
            PG8_LDA(At, 0, 1); PG8_STAGE(PG8_SB(0, 0), b2, voffB); PG8_STAGE(PG8_SB(0, 1), b2 + hstepB, voffB); PG8_STAGE(PG8_SA(0, 0), a2, voffA);
            PG8_WAIT_V(8); PG8_WAIT_L(0); PG8_BAR; PG8_MMA(1, 0, At, B0); PG8_MMA(1, 1, At, B1); PG8_BAR; PG8_SCHED;
            PG8_LDB(B0, 1, 0); PG8_LDB(B1, 1, 1); PG8_SCHED; PG8_LDA(At, 1, 0); PG8_STAGE(PG8_SA(0, 1), a2 + hstepA, voffA);
            PG8_WAIT_V(8); PG8_WAIT_L(0); PG8_BAR; PG8_MMA(0, 0, At, B0); PG8_MMA(0, 1, At, B1); PG8_BAR; PG8_SCHED;
            PG8_LDA(At, 1, 1); PG8_STAGE(PG8_SB(1, 0), b3, voffB); PG8_STAGE(PG8_SB(1, 1), b3 + hstepB, voffB); PG8_STAGE(PG8_SA(1, 0), a3, voffA);
            PG8_WAIT_V(8); PG8_WAIT_L(0); PG8_BAR; PG8_MMA(1, 0, At, B0); PG8_MMA(1, 1, At, B1); PG8_BAR; PG8_SCHED;
            } else {
            PG8_LDB(B0, 0, 0); PG8_SCHED; PG8_LDA(At, 0, 0); PG8_STAGE(PG8_SA(1, 1), a1 + hstepA, voffA);
            PG8_WAIT_L(8); PG8_BAR; PG8_WAIT_L(0); PG8_MMA(0, 0, At, B0); PG8_BAR; PG8_SCHED;
            PG8_LDB(B1, 0, 1); PG8_STAGE(PG8_SB(0, 0), b2, voffB);
            PG8_BAR; PG8_WAIT_L(0); PG8_MMA(0, 1, At, B1); PG8_BAR;
            PG8_LDA(At, 0, 1); PG8_STAGE(PG8_SA(0, 0), a2, voffA);
            PG8_BAR; PG8_WAIT_L(0); PG8_MMA(1, 0, At, B0); PG8_BAR; PG8_SCHED;
            PG8_STAGE(PG8_SB(0, 1), b2 + hstepB, voffB);
            PG8_WAIT_V(6); PG8_BAR; PG8_MMA(1, 1, At, B1); PG8_BAR;
            PG8_LDB(B0, 1, 0); PG8_SCHED; PG8_LDA(At, 1, 0); PG8_STAGE(PG8_SA(0, 1), a2 + hstepA, voffA);
            PG8_WAIT_L(8); PG8_BAR; PG8_WAIT_L(0); PG8_MMA(0, 0, At, B0); PG8_BAR; PG8_SCHED;
            PG8_LDB(B1, 1, 1); PG8_STAGE(PG8_SB(1, 0), b3, voffB);
            PG8_BAR; PG8_WAIT_L(0); PG8_MMA(0, 1, At, B1); PG8_BAR;
            PG8_LDA(At, 1, 1); PG8_STAGE(PG8_SA(1, 0), a3, voffA);
            PG8_BAR; PG8_WAIT_L(0); PG8_MMA(1, 0, At, B0); PG8_BAR; PG8_SCHED;
            PG8_STAGE(PG8_SB(1, 1), b3 + hstepB, voffB);
            PG8_WAIT_V(6); PG8_BAR; PG8_MMA(1, 1, At, B1); PG8_BAR;
            }
        }
        if constexpr (ALIGN_EPI) { if (wr == 0) PG8_BAR; }
        if constexpr (!Epi::AFTER_DRAIN) { E(acc, cur, wr, wc, fr, fq); S.done(cur); }
        if (!has_next) break;
#pragma unroll
        for (int a = 0; a < 2; ++a)
#pragma unroll
            for (int b = 0; b < 2; ++b)
#pragma unroll
                for (int m = 0; m < 4; ++m)
#pragma unroll
                    for (int n = 0; n < 2; ++n) acc[a][b][m][n] = (f32x4){0.f, 0.f, 0.f, 0.f};
        cur = nxt; cA = nA; cB = nB; ++ui;
        if constexpr (ALIGN_EPI) { if (wr == 1) PG8_BAR; }
    }
    PG8_WAIT_V(0);
    if constexpr (!ALIGN_EPI) { if (wr == 0) PG8_BAR; }
    PG8_BAR;
    if constexpr (Epi::AFTER_DRAIN) { E.fused(acc, cur, wr, wc, fr, fq, lds, wid, lane); S.done(cur); }
#undef PG8_SA
#undef PG8_SB
#undef PG8_STAGE
#undef PG8_LDA
#undef PG8_LDB
#undef PG8_MMA
#undef PG8_WAIT_V
#undef PG8_WAIT_L
#undef PG8_BAR
#undef PG8_SCHED
}
}
#define GAS __attribute__((address_space(1)))
#define LAS __attribute__((address_space(3)))
typedef unsigned short bf16;
typedef unsigned v4u __attribute__((ext_vector_type(4)));
typedef float f32x4 __attribute__((ext_vector_type(4)));
typedef short bf16x8 __attribute__((ext_vector_type(8)));
typedef GAS unsigned gu32;
typedef GAS unsigned long long gu64;
#define RLX_AGENT __ATOMIC_RELAXED, __HIP_MEMORY_SCOPE_AGENT
#define LDS_WAIT() asm volatile("s_waitcnt lgkmcnt(0)" ::: "memory")
#define VM_WAIT() asm volatile("s_waitcnt vmcnt(0)" ::: "memory")
__device__ __forceinline__ unsigned long long rt() { return __builtin_amdgcn_s_memrealtime(); }
__device__ __forceinline__ unsigned f2bf(float f) { unsigned u = __builtin_bit_cast(unsigned, f); return (u + 0x7fffu + ((u >> 16) & 1u)) >> 16; }
__device__ __forceinline__ unsigned pk2(float lo, float hi) { return f2bf(lo) | (f2bf(hi) << 16); }

#define XB_TMO      128
#define XB_XCNT(j)  (256  + 64 * (j))
#define XB_XSUB(j)  (1280 + 64 * (j))
#define XB_XGEN(j)  (2304 + 64 * (j))
#define XB_TOP      3328
#define XB_TOPGEN   3392
#define XCD_BAR_WORDS 3456
#define XB_SPIN_CAP (1u << 18)

__device__ __forceinline__ unsigned xb_ld(unsigned* p)              { return __hip_atomic_load(p, __ATOMIC_RELAXED, __HIP_MEMORY_SCOPE_AGENT); }
__device__ __forceinline__ unsigned xb_add(unsigned* p, unsigned v) { return __hip_atomic_fetch_add(p, v, __ATOMIC_RELAXED, __HIP_MEMORY_SCOPE_AGENT); }
__device__ __forceinline__ unsigned xb_xcc_id() { return (unsigned)__builtin_amdgcn_s_getreg((3 << 11) | 20) & 0xFu; }
#define XB_SPIN(cond, bar) do { unsigned _sp = 0; while (cond) { __builtin_amdgcn_s_sleep(1); \
    if ((++_sp & 255u) == 0u) { if (xb_ld(&(bar)[XB_TMO])) break; if (_sp > XB_SPIN_CAP) { atomicAdd(&(bar)[XB_TMO], 1u); break; } } } } while (0)

struct XcdBarrier {
    unsigned* bar; unsigned x;
    volatile LAS unsigned* st;
};

__device__ __forceinline__ XcdBarrier xcd_barrier_post(unsigned* bar, volatile LAS unsigned* st) {
    XcdBarrier b; b.bar = bar; b.x = xb_xcc_id(); b.st = st;
    if (threadIdx.x == 0) (void)xb_add(&bar[XB_XCNT(b.x)], 1u);
    return b;
}
__device__ __forceinline__ void xcd_barrier_complete(unsigned* bar, unsigned x, unsigned& nloc, unsigned& nx) {
    const unsigned G = gridDim.x * gridDim.y * gridDim.z;
    unsigned sum, cnt, mine, sp = 0u;
    for (;;) {
        sum = 0u; cnt = 0u; mine = 0u;
#pragma unroll
        for (unsigned j = 0; j < 16; ++j) { const unsigned c = xb_ld(&bar[XB_XCNT(j)]); sum += c; cnt += (c > 0u) ? 1u : 0u; mine = (j == x) ? c : mine; }
        if (sum == G) break;
        __builtin_amdgcn_s_sleep(1);
        if ((++sp & 255u) == 0u) { if (xb_ld(&bar[XB_TMO])) break; if (sp > XB_SPIN_CAP) { atomicAdd(&bar[XB_TMO], 1u); break; } }
    }
    nloc = mine > 0u ? mine : 1u; nx = cnt > 0u ? cnt : 1u;
}

__device__ __forceinline__ void xcd_barrier(const XcdBarrier& b) {
    asm volatile("s_waitcnt vmcnt(0)" ::: "memory");
    __syncthreads();
    if (threadIdx.x == 0) {
        unsigned* bar = b.bar;
        __builtin_amdgcn_s_waitcnt(0);
        unsigned nloc = b.st[0], nx = b.st[1];
        if (nloc == 0u) { xcd_barrier_complete(bar, b.x, nloc, nx); b.st[0] = nloc; b.st[1] = nx; }
        const unsigned old = xb_add(&bar[XB_XSUB(b.x)], 1u);
        const unsigned gen = old / nloc;
        if (old + 1u == (gen + 1u) * nloc) {
            __builtin_amdgcn_fence(__ATOMIC_RELEASE, "agent");
            asm volatile("s_waitcnt vmcnt(0)" ::: "memory");
            const unsigned og = xb_add(&bar[XB_TOP], 1u);
            const unsigned tg = og / nx;
            if (og + 1u == (tg + 1u) * nx) xb_add(&bar[XB_TOPGEN], 1u);
            else XB_SPIN(xb_ld(&bar[XB_TOPGEN]) == tg, bar);
            __builtin_amdgcn_fence(__ATOMIC_ACQUIRE, "agent");
            xb_add(&bar[XB_XGEN(b.x)], 1u);
            asm volatile("s_waitcnt vmcnt(0)" ::: "memory");
        } else {
            XB_SPIN(xb_ld(&bar[XB_XGEN(b.x)]) == gen, bar);
            __builtin_amdgcn_fence(__ATOMIC_ACQUIRE, "agent");
            asm volatile("s_waitcnt vmcnt(0)" ::: "memory");
        }
    }
    __syncthreads();
}

constexpr int T_ = 8192, NBATCH = 2, DM = 1024, CTXL = 256;
constexpr int MLAT = NBATCH * T_, MCTX = NBATCH * CTXL, MALL = MLAT + MCTX;
constexpr int NPL = 4864;
constexpr int C_QM = 0, C_KM = 512, C_VM = 1024, C_OM = 1536, C_AQ = 2048, C_AK = 2560, C_AV = 2688, C_GM = 2816, C_GA = 3840;
constexpr int NBLK = 66;
constexpr float EPS = 1e-6f, LOG2E = 1.4426950408889634f;
constexpr int NWAVES = 8, NTHR = 512;

constexpr size_t MiB = 1u << 20;
constexpr size_t WS_CTL = 0, CTL_ZERO_BYTES = 64 * 1024;
constexpr int    CW_BAR = 4096;
constexpr size_t WS_MOD  = 1 * MiB;
constexpr size_t WS_ROPE = 1 * MiB + 128 * 1024;
constexpr size_t WS_WG   = 1 * MiB + 256 * 1024;
constexpr size_t WS_SK   = 1 * MiB + 512 * 1024;
constexpr size_t WS_WIN  = 2 * MiB;
constexpr size_t WS_WBM  = 12 * MiB, WS_WBA = 13 * MiB;
constexpr size_t WS_WOUT = 14 * MiB;
constexpr size_t WS_WQ   = 16 * MiB;
constexpr size_t WS_GATE = 20 * MiB;
constexpr size_t WS_SC   = 22 * MiB;
constexpr size_t WS_NS   = 22 * MiB + 64 * 1024;
constexpr size_t WS_XN   = 24 * MiB;
constexpr size_t WS_PL   = 58 * MiB;
constexpr size_t WS_U16  = 58 * MiB, WS_V16 = 90 * MiB;
constexpr size_t WS_Q    = 122 * MiB;
constexpr size_t WS_END  = 215 * MiB;
static_assert(WS_PL + (size_t)MALL * NPL * 2 <= WS_END && WS_Q + (size_t)MLAT * 2048 * 2 <= WS_END, "ws map");

constexpr int LDS_BYTES = 163840 - 256;
constexpr int MISC_OFF = LDS_BYTES - 256;

struct Args { const float* in[21]; float* out; unsigned char* ws; int ph_lo, ph_hi; };

typedef unsigned v2u __attribute__((ext_vector_type(2)));
typedef unsigned short u16;

__device__ __forceinline__ float bf2f(unsigned h) { return __builtin_bit_cast(float, h << 16); }
__device__ __forceinline__ float bflo(unsigned w) { return __builtin_bit_cast(float, w << 16); }
__device__ __forceinline__ float bfhi(unsigned w) { return __builtin_bit_cast(float, w & 0xffff0000u); }
__device__ __forceinline__ float wave_sum(float v) {
#pragma unroll
    for (int o = 1; o < 64; o <<= 1) v += __shfl_xor(v, o);
    return v;
}
__device__ __forceinline__ float wave_max(float v) {
#pragma unroll
    for (int o = 1; o < 64; o <<= 1) v = fmaxf(v, __shfl_xor(v, o));
    return v;
}
__device__ __forceinline__ float sigmoidf_(float x) { return 1.f / (1.f + __expf(-x)); }
__device__ __forceinline__ float siluf_(float x) { return x / (1.f + __expf(-x)); }
__device__ __forceinline__ float logsigmoidf_(float x) { return fminf(x, 0.f) - log1pf(__expf(-fabsf(x))); }
__device__ __forceinline__ float gelu_tanh(float x) { const float u = 0.7978845608028654f * (x + 0.044715f * x * x * x); const float t = 1.f - 2.f / (__expf(2.f * u) + 1.f); return 0.5f * x * (1.f + t); }
__device__ __forceinline__ f32x4 mfma16(bf16x8 a, bf16x8 b, f32x4 c) { return __builtin_amdgcn_mfma_f32_16x16x32_bf16(a, b, c, 0, 0, 0); }
__device__ __forceinline__ bf16x8 as_bf16x8(v4u v) { return __builtin_bit_cast(bf16x8, v); }

__device__ __forceinline__ void p0_transpose_item(const float* W, int ldw, int K, bf16* WT, int n_dst0, int n_src0, int k0, float scale, LAS float* scr, int lane) {
#pragma unroll 8
    for (int i = 0; i < 32; ++i) { const int kk = 2 * i + (lane >> 5); scr[kk * 33 + (lane & 31)] = W[(size_t)(k0 + kk) * ldw + n_src0 + (lane & 31)]; }
    LDS_WAIT(); asm volatile("" ::: "memory");
    const int c = lane & 7;
#pragma unroll
    for (int j = 0; j < 4; ++j) { const int n = (lane >> 3) + 8 * j; const LAS float* s = scr + (8 * c) * 33 + n;
        v4u o; o.x = pk2(s[0 * 33] * scale, s[1 * 33] * scale); o.y = pk2(s[2 * 33] * scale, s[3 * 33] * scale); o.z = pk2(s[4 * 33] * scale, s[5 * 33] * scale); o.w = pk2(s[6 * 33] * scale, s[7 * 33] * scale);
        *(GAS v4u*)(WT + (size_t)(n_dst0 + n) * K + k0 + 8 * c) = o; }
    LDS_WAIT(); asm volatile("" ::: "memory");
}

__device__ __forceinline__ void p0_prologue(const Args& A, LAS unsigned char* lds, int tid, int lane, int wave, int vcu, int G) {
    unsigned char* ws = A.ws;
    LAS float* scr = (LAS float*)(lds + wave * 16384);
    const int gw = vcu * NWAVES + wave, NGW = G * NWAVES;
    const float* c_in = A.in[1]; const float* cctx = A.in[3]; const float* w_ada = A.in[4]; const float* b_ada = A.in[5];
    float* MOD = (float*)(ws + WS_MOD);
    constexpr int I_GEMV = 192, I_WIN = 16 * 152, I_WB = 8 * 32, I_WO = 16 * 32, I_WQ = 16 * 64;
    constexpr int NITEMS = I_GEMV + I_WIN + 2 * I_WB + I_WO + I_WQ;
    for (int it = gw; it < NITEMS; it += NGW) {
        int r = it;
        if (r < I_GEMV) {
            const int n0 = 32 * r, cg = lane & 7, rg = lane >> 3;
            float acc[3][4];
#pragma unroll
            for (int b = 0; b < 3; ++b)
#pragma unroll
                for (int e = 0; e < 4; ++e) acc[b][e] = 0.f;
            const float* wp = w_ada + n0 + 4 * cg;
#pragma unroll 4
            for (int k = rg; k < 1024; k += 8) {
                const f32x4 w = *(const f32x4*)(wp + (size_t)k * 6144);
                const float s0 = siluf_(c_in[k]), s1 = siluf_(c_in[1024 + k]), s2 = siluf_(cctx[k]);
#pragma unroll
                for (int e = 0; e < 4; ++e) { acc[0][e] += s0 * w[e]; acc[1][e] += s1 * w[e]; acc[2][e] += s2 * w[e]; }
            }
#pragma unroll
            for (int b = 0; b < 3; ++b)
#pragma unroll
                for (int e = 0; e < 4; ++e) { float v = acc[b][e]; v += __shfl_xor(v, 8); v += __shfl_xor(v, 16); v += __shfl_xor(v, 32); acc[b][e] = v; }
            if (rg == 0) {
                const f32x4 bb = *(const f32x4*)(b_ada + n0 + 4 * cg);
#pragma unroll
                for (int b = 0; b < 3; ++b) { f32x4 o; o.x = acc[b][0] + bb.x; o.y = acc[b][1] + bb.y; o.z = acc[b][2] + bb.z; o.w = acc[b][3] + bb.w; *(f32x4*)(MOD + b * 6144 + n0 + 4 * cg) = o; }
            }
            continue;
        }
        r -= I_GEMV;
        if (r < I_WIN) { const int kb = r / 152, nb = r % 152, n0 = 32 * nb; const int nsrc = n0 < 2048 ? n0 : n0 + 16;
            const float sc = (n0 >= C_KM && n0 < C_VM) ? 0.08838834764831845f : 1.0f;
            p0_transpose_item(A.in[8], 4880, 1024, (bf16*)(ws + WS_WIN), n0, nsrc, 64 * kb, sc, scr, lane); continue; }
        r -= I_WIN;
        if (r < I_WB) { p0_transpose_item(A.in[14], 1024, 512, (bf16*)(ws + WS_WBM), 32 * (r % 32), 32 * (r % 32), 64 * (r / 32), 1.f, scr, lane); continue; }
        r -= I_WB;
        if (r < I_WB) { p0_transpose_item(A.in[15], 1024, 512, (bf16*)(ws + WS_WBA), 32 * (r % 32), 32 * (r % 32), 64 * (r / 32), 1.f, scr, lane); continue; }
        r -= I_WB;
        if (r < I_WO) { p0_transpose_item(A.in[16], 1024, 1024, (bf16*)(ws + WS_WOUT), 32 * (r % 32), 32 * (r % 32), 64 * (r / 32), 1.f, scr, lane); continue; }
        r -= I_WO;
        p0_transpose_item(A.in[17], 2048, 1024, (bf16*)(ws + WS_WQ), 32 * (r % 64), 32 * (r % 64), 64 * (r / 64), 1.f, scr, lane);
    }
    const int gt = vcu * NTHR + tid, NGT = G * NTHR;
    { const float* sk = A.in[18]; bf16* SK = (bf16*)(ws + WS_SK);
      for (int i = gt; i < 8 * 2 * 128 * 128 / 4; i += NGT) { const f32x4 v = *(const f32x4*)(sk + 4 * (size_t)i); v2u o; o.x = pk2(v.x, v.y); o.y = pk2(v.z, v.w); *(v2u*)(SK + 4 * (size_t)i) = o; } }
    { const float* w_in = A.in[8]; float* WG = (float*)(ws + WS_WG);
      for (int i = gt; i < 16 * 1024; i += NGT) { const int g = i >> 10, k = i & 1023; WG[i] = w_in[(size_t)k * 4880 + 2048 + g]; } }
    { float* rope = (float*)(ws + WS_ROPE);
      for (int i = gt; i < 192 * 16; i += NGT) { const int p = i >> 4, f = i & 15; const int pos = p < 128 ? p : p - 128;
          const float inv = powf(10000.0f, -(float)f / 16.0f); const float ang = (float)pos * inv; rope[2 * i] = cosf(ang); rope[2 * i + 1] = sinf(ang); } }
}

__device__ __forceinline__ void p1_prenorm(const Args& A, LAS unsigned char* lds, int tid, int lane, int wave, int vcu, int G) {
    unsigned char* ws = A.ws;
    LAS float* WGL = (LAS float*)lds;
    { const float* WG = (const float*)(ws + WS_WG);
      for (int i = tid; i < 16 * 1024 / 4; i += NTHR) *(LAS f32x4*)(WGL + 4 * i) = *(const f32x4*)(WG + 4 * i); }
    __syncthreads();
    const float* x = A.in[0]; const float* ctx = A.in[2]; const float* ng = A.in[6]; const float* bmg = A.in[9];
    const float* MOD = (const float*)(ws + WS_MOD);
    bf16* XN = (bf16*)(ws + WS_XN); float* GATE = (float*)(ws + WS_GATE);
    const int gw = vcu * NWAVES + wave, NGW = G * NWAVES;
    for (int r = gw; r < MALL; r += NGW) {
        const float* src = r < MLAT ? x + (size_t)r * DM : ctx + (size_t)(r - MLAT) * DM;
        const float* mrow = MOD + (r < MLAT ? (r / T_) : 2) * 6144;
        f32x4 v[4]; float ss = 0.f;
#pragma unroll
        for (int j = 0; j < 4; ++j) { v[j] = *(const f32x4*)(src + 4 * lane + 256 * j); ss += (v[j].x * v[j].x + v[j].y * v[j].y) + (v[j].z * v[j].z + v[j].w * v[j].w); }
        const float rstd = rsqrtf(wave_sum(ss) * (1.f / DM) + EPS);
#pragma unroll
        for (int j = 0; j < 4; ++j) { const int c = 4 * lane + 256 * j;
            const f32x4 g = *(const f32x4*)(ng + c), sh = *(const f32x4*)(mrow + c), sc = *(const f32x4*)(mrow + 1024 + c);
            v[j].x = v[j].x * rstd * g.x * (1.f + sc.x) + sh.x; v[j].y = v[j].y * rstd * g.y * (1.f + sc.y) + sh.y;
            v[j].z = v[j].z * rstd * g.z * (1.f + sc.z) + sh.z; v[j].w = v[j].w * rstd * g.w * (1.f + sc.w) + sh.w;
            v2u o; o.x = pk2(v[j].x, v[j].y); o.y = pk2(v[j].z, v[j].w); *(v2u*)(XN + (size_t)r * DM + c) = o; }
        float mine = 0.f;
#pragma unroll 2
        for (int gi = 0; gi < 16; ++gi) {
            float p = 0.f;
#pragma unroll
            for (int j = 0; j < 4; ++j) { const f32x4 w = *(const LAS f32x4*)(WGL + gi * 1024 + 4 * lane + 256 * j); p += (v[j].x * w.x + v[j].y * w.y) + (v[j].z * w.z + v[j].w * w.w); }
            p = wave_sum(p);
            if (lane == gi) mine = p;
        }
        if (lane < 16) { float gv = mine + bmg[lane]; if ((lane >> 2) & 1) gv = logsigmoidf_(gv); GATE[(size_t)r * 16 + lane] = gv; }
    }
}

struct EpiPL {
    static constexpr bool PERM = true, AFTER_DRAIN = false;
    bf16* O;
    __device__ __forceinline__ void operator()(const pg8::f32x4 (&acc)[2][2][4][2], const pg8::Unit& u, int wr, int wc, int fr, int fq) const {
        const int row0 = u.pm * 256 + wr * 64 + fr, col0 = u.pn * 256 + wc * 32 + 8 * fq;
        const bool sig = (u.pn == 6) || (u.pn == 7) || (u.pn >= 11);
#pragma unroll
        for (int ai = 0; ai < 2; ++ai)
#pragma unroll
            for (int m = 0; m < 4; ++m) { bf16* rowp = O + (size_t)(row0 + ai * 128 + m * 16) * NPL + col0;
#pragma unroll
                for (int bj = 0; bj < 2; ++bj) { f32x4 v0 = acc[ai][bj][m][0], v1 = acc[ai][bj][m][1];
                    if (sig) {
#pragma unroll
                        for (int e = 0; e < 4; ++e) { v0[e] = sigmoidf_(v0[e]); v1[e] = sigmoidf_(v1[e]); } }
                    v4u w; w.x = pg8::cvt_pk_bf16(v0[0], v0[1]); w.y = pg8::cvt_pk_bf16(v0[2], v0[3]); w.z = pg8::cvt_pk_bf16(v1[0], v1[1]); w.w = pg8::cvt_pk_bf16(v1[2], v1[3]);
                    *(v4u*)(rowp + bj * 128) = w; } }
    }
};
template <int SECOND> struct EpiMerge {
    static constexpr bool PERM = true, AFTER_DRAIN = false;
    bf16* Mg; const bf16* PLg;
    __device__ __forceinline__ void operator()(const pg8::f32x4 (&acc)[2][2][4][2], const pg8::Unit& u, int wr, int wc, int fr, int fq) const {
        const int row0 = u.pm * 256 + wr * 64 + fr, col0 = u.pn * 256 + wc * 32 + 8 * fq;
#pragma unroll
        for (int ai = 0; ai < 2; ++ai)
#pragma unroll
            for (int m = 0; m < 4; ++m) { const size_t r = (size_t)(row0 + ai * 128 + m * 16);
#pragma unroll
                for (int bj = 0; bj < 2; ++bj) { const int c = col0 + bj * 128;
                    const v4u gw = *(const v4u*)(PLg + r * NPL + c);
                    f32x4 v0 = acc[ai][bj][m][0], v1 = acc[ai][bj][m][1];
                    v0[0] *= bflo(gw.x); v0[1] *= bfhi(gw.x); v0[2] *= bflo(gw.y); v0[3] *= bfhi(gw.y); v1[0] *= bflo(gw.z); v1[1] *= bfhi(gw.z); v1[2] *= bflo(gw.w); v1[3] *= bfhi(gw.w);
                    if (SECOND) { const v4u pw = *(const v4u*)(Mg + r * DM + c);
                        v0[0] += bflo(pw.x); v0[1] += bfhi(pw.x); v0[2] += bflo(pw.y); v0[3] += bfhi(pw.y); v1[0] += bflo(pw.z); v1[1] += bfhi(pw.z); v1[2] += bflo(pw.w); v1[3] += bfhi(pw.w); }
                    v4u w; w.x = pg8::cvt_pk_bf16(v0[0], v0[1]); w.y = pg8::cvt_pk_bf16(v0[2], v0[3]); w.z = pg8::cvt_pk_bf16(v1[0], v1[1]); w.w = pg8::cvt_pk_bf16(v1[2], v1[3]);
                    *(v4u*)(Mg + r * DM + c) = w; } }
    }
};
struct EpiOut {
    static constexpr bool PERM = false, AFTER_DRAIN = false;
    const float* x; float* out; const float* MOD;
    __device__ __forceinline__ void operator()(const pg8::f32x4 (&acc)[2][2][4][2], const pg8::Unit& u, int wr, int wc, int fr, int fq) const {
        const int row0 = u.pm * 256 + wr * 64 + fr, col0 = u.pn * 256 + wc * 32 + 4 * fq;
        const float* g1 = MOD + ((u.pm * 256) / T_) * 6144 + 2 * 1024;
#pragma unroll
        for (int bj = 0; bj < 2; ++bj)
#pragma unroll
            for (int n = 0; n < 2; ++n) { const int c = col0 + bj * 128 + n * 16; const f32x4 gv = *(const f32x4*)(g1 + c);
#pragma unroll
                for (int ai = 0; ai < 2; ++ai)
#pragma unroll
                    for (int m = 0; m < 4; ++m) { const size_t off = (size_t)(row0 + ai * 128 + m * 16) * DM + c;
                        const f32x4 xv = *(const f32x4*)(x + off); *(f32x4*)(out + off) = xv + gv * acc[ai][bj][m][n]; } }
    }
};
struct EpiQ {
    static constexpr bool PERM = true, AFTER_DRAIN = false;
    bf16* O;
    __device__ __forceinline__ void operator()(const pg8::f32x4 (&acc)[2][2][4][2], const pg8::Unit& u, int wr, int wc, int fr, int fq) const {
        const int row0 = u.pm * 256 + wr * 64 + fr, col0 = u.pn * 256 + wc * 32 + 8 * fq;
#pragma unroll
        for (int ai = 0; ai < 2; ++ai)
#pragma unroll
            for (int m = 0; m < 4; ++m) { bf16* rowp = O + (size_t)(row0 + ai * 128 + m * 16) * 2048 + col0;
#pragma unroll
                for (int bj = 0; bj < 2; ++bj) { const f32x4 v0 = acc[ai][bj][m][0], v1 = acc[ai][bj][m][1];
                    v4u w; w.x = pg8::cvt_pk_bf16(v0[0], v0[1]); w.y = pg8::cvt_pk_bf16(v0[2], v0[3]); w.z = pg8::cvt_pk_bf16(v1[0], v1[1]); w.w = pg8::cvt_pk_bf16(v1[2], v1[3]);
                    *(v4u*)(rowp + bj * 128) = w; } }
    }
};

constexpr int AT_PITCH = 72;
constexpr int AT_QS = 0, AT_KS = 8 * 64 * AT_PITCH * 2, AT_VT = AT_KS + 64 * AT_PITCH * 2;
__device__ __forceinline__ void attn_unit(const Args& A, LAS unsigned char* lds, int unit, int tid, int lane, int wave) {
    const int b = unit >> 7, g = (unit >> 6) & 1, nb = unit & 63;
    bf16* PL = (bf16*)(A.ws + WS_PL);
    const float* rope = (const float*)(A.ws + WS_ROPE);
    const float* qg = A.in[11]; const float* kg = A.in[12]; const float* sink = A.in[13];
    const int hq = 4 * g + (wave >> 1), rh = wave & 1;
    const int q0w = nb * 128 + rh * 64;
    const int l15 = lane & 15, a4 = lane >> 4;
    LAS bf16* QS = (LAS bf16*)(lds + AT_QS) + wave * (64 * AT_PITCH);
    LAS bf16* KS = (LAS bf16*)(lds + AT_KS);
    LAS bf16* VT = (LAS bf16*)(lds + AT_VT);
    __syncthreads();
    {
        const int t = q0w + lane;
        const bf16* src = PL + (size_t)(b * T_ + t) * NPL + C_AQ + hq * 64;
        float ss = 0.f;
#pragma unroll
        for (int c = 0; c < 8; ++c) { const v4u raw = *(const v4u*)(src + 8 * c);
            const float x0 = bflo(raw.x), x1 = bfhi(raw.x), x2 = bflo(raw.y), x3 = bfhi(raw.y), x4 = bflo(raw.z), x5 = bfhi(raw.z), x6 = bflo(raw.w), x7 = bfhi(raw.w);
            ss += (x0 * x0 + x1 * x1) + (x2 * x2 + x3 * x3) + (x4 * x4 + x5 * x5) + (x6 * x6 + x7 * x7); }
        const float rs = rsqrtf(ss * (1.f / 64.f) + EPS) * (0.125f * LOG2E);
        asm volatile("" ::: "memory");
#pragma unroll
        for (int c = 0; c < 4; ++c) {
            const v4u ra = *(const v4u*)(src + 8 * c), rb = *(const v4u*)(src + 32 + 8 * c);
            const float* tab = c < 2 ? rope + ((t >> 6) * 16 + 8 * c) * 2 : rope + ((128 + (t & 63)) * 16 + 8 * c - 16) * 2;
            const unsigned wa[4] = {ra.x, ra.y, ra.z, ra.w}, wb[4] = {rb.x, rb.y, rb.z, rb.w};
            unsigned oa[4], ob[4];
#pragma unroll
            for (int e = 0; e < 4; ++e) {
                const float a0 = bflo(wa[e]) * rs * qg[8 * c + 2 * e], a1 = bfhi(wa[e]) * rs * qg[8 * c + 2 * e + 1];
                const float b0 = bflo(wb[e]) * rs * qg[32 + 8 * c + 2 * e], b1 = bfhi(wb[e]) * rs * qg[32 + 8 * c + 2 * e + 1];
                const f32x4 cssn = *(const f32x4*)(tab + 4 * e);
                oa[e] = pk2(a0 * cssn.x - b0 * cssn.y, a1 * cssn.z - b1 * cssn.w);
                ob[e] = pk2(b0 * cssn.x + a0 * cssn.y, b1 * cssn.z + a1 * cssn.w);
            }
            v4u o; o.x = oa[0]; o.y = oa[1]; o.z = oa[2]; o.w = oa[3]; *(LAS v4u*)(QS + lane * AT_PITCH + 8 * c) = o;
            v4u p; p.x = ob[0]; p.y = ob[1]; p.z = ob[2]; p.w = ob[3]; *(LAS v4u*)(QS + lane * AT_PITCH + 32 + 8 * c) = p;
            asm volatile("" ::: "memory");
        }
    }
    LDS_WAIT(); asm volatile("" ::: "memory");
    bf16x8 qf[4][2];
#pragma unroll
    for (int qt = 0; qt < 4; ++qt)
#pragma unroll
        for (int ks = 0; ks < 2; ++ks) qf[qt][ks] = *(const LAS bf16x8*)(QS + (qt * 16 + l15) * AT_PITCH + 32 * ks + 8 * a4);
    f32x4 ot[4][4];
    float mrun[4], lsum[4];
#pragma unroll
    for (int i = 0; i < 4; ++i) { mrun[i] = -1e30f; lsum[i] = 0.f;
#pragma unroll
        for (int j = 0; j < 4; ++j) ot[i][j] = (f32x4){0.f, 0.f, 0.f, 0.f}; }

    for (int idx = 0; idx < 10; ++idx) {
        const bool local = idx < 6;
        const int lb = nb - 1 + (idx >> 1);
        if (local && (lb < 0 || lb > 63)) continue;
        const int kstart = lb * 128 + (idx & 1) * 64;
        __syncthreads();
        {
            const int key = tid >> 3, c = tid & 7;
            const size_t rowi = local ? (size_t)(b * T_ + kstart + key) : (size_t)(MLAT + b * CTXL + (idx - 6) * 64 + key);
            const v4u kr = *(const v4u*)(PL + rowi * NPL + C_AK + g * 64 + 8 * c);
            const v4u vr = *(const v4u*)(PL + rowi * NPL + C_AV + g * 64 + 8 * c);
            float y[8]; y[0] = bflo(kr.x); y[1] = bfhi(kr.x); y[2] = bflo(kr.y); y[3] = bfhi(kr.y); y[4] = bflo(kr.z); y[5] = bfhi(kr.z); y[6] = bflo(kr.w); y[7] = bfhi(kr.w);
            float ss = 0.f;
#pragma unroll
            for (int e = 0; e < 8; ++e) ss += y[e] * y[e];
            ss += __shfl_xor(ss, 1); ss += __shfl_xor(ss, 2); ss += __shfl_xor(ss, 4);
            const float rstd = rsqrtf(ss * (1.f / 64.f) + EPS);
#pragma unroll
            for (int e = 0; e < 8; ++e) y[e] = y[e] * rstd * kg[8 * c + e];
            if (local) {
                const int kpos = kstart + key;
                const float* tab = (c & 3) < 2 ? rope + ((kpos >> 6) * 16 + 8 * (c & 3)) * 2 : rope + ((128 + (kpos & 63)) * 16 + 8 * (c & 3) - 16) * 2;
#pragma unroll
                for (int e = 0; e < 8; ++e) { const float yp = __shfl_xor(y[e], 4); const float cs = tab[2 * e], sn = tab[2 * e + 1];
                    y[e] = c < 4 ? y[e] * cs - yp * sn : y[e] * cs + yp * sn; }
            }
            v4u o; o.x = pk2(y[0], y[1]); o.y = pk2(y[2], y[3]); o.z = pk2(y[4], y[5]); o.w = pk2(y[6], y[7]);
            *(LAS v4u*)(KS + key * AT_PITCH + 8 * c) = o;
            LAS u16* vt = (LAS u16*)VT + (8 * c) * AT_PITCH + key;
            vt[0 * AT_PITCH] = (u16)(vr.x & 0xffffu); vt[1 * AT_PITCH] = (u16)(vr.x >> 16); vt[2 * AT_PITCH] = (u16)(vr.y & 0xffffu); vt[3 * AT_PITCH] = (u16)(vr.y >> 16);
            vt[4 * AT_PITCH] = (u16)(vr.z & 0xffffu); vt[5 * AT_PITCH] = (u16)(vr.z >> 16); vt[6 * AT_PITCH] = (u16)(vr.w & 0xffffu); vt[7 * AT_PITCH] = (u16)(vr.w >> 16);
        }
        __syncthreads();
#pragma unroll
        for (int qh = 0; qh < 2; ++qh) {
            f32x4 st[4][2];
#pragma unroll
            for (int kt = 0; kt < 4; ++kt) {
                const bf16x8 ka0 = *(const LAS bf16x8*)(KS + (kt * 16 + l15) * AT_PITCH + 8 * a4);
                const bf16x8 ka1 = *(const LAS bf16x8*)(KS + (kt * 16 + l15) * AT_PITCH + 32 + 8 * a4);
#pragma unroll
                for (int q2 = 0; q2 < 2; ++q2) { f32x4 z = (f32x4){0.f, 0.f, 0.f, 0.f}; z = mfma16(ka0, qf[2 * qh + q2][0], z); st[kt][q2] = mfma16(ka1, qf[2 * qh + q2][1], z); }
            }
            if (local && lb != nb) {
#pragma unroll
                for (int kt = 0; kt < 4; ++kt)
#pragma unroll
                    for (int q2 = 0; q2 < 2; ++q2)
#pragma unroll
                        for (int i = 0; i < 4; ++i) { const int dlt = (kstart + kt * 16 + 4 * a4 + i) - (q0w + (2 * qh + q2) * 16 + l15);
                            if (dlt > 128 || dlt < -128) st[kt][q2][i] = -INFINITY; }
            }
            bf16x8 pf[2][2];
#pragma unroll
            for (int q2 = 0; q2 < 2; ++q2) {
                const int qt = 2 * qh + q2;
                float mx = -INFINITY;
#pragma unroll
                for (int kt = 0; kt < 4; ++kt)
#pragma unroll
                    for (int i = 0; i < 4; ++i) mx = fmaxf(mx, st[kt][q2][i]);
                mx = fmaxf(mx, __shfl_xor(mx, 16)); mx = fmaxf(mx, __shfl_xor(mx, 32));
                const float mnew = fmaxf(mrun[qt], mx);
                const float alpha = exp2f(mrun[qt] - mnew);
                mrun[qt] = mnew;
                float ps = 0.f;
#pragma unroll
                for (int kt = 0; kt < 4; ++kt)
#pragma unroll
                    for (int i = 0; i < 4; ++i) { const float p = exp2f(st[kt][q2][i] - mnew); st[kt][q2][i] = p; ps += p; }
                lsum[qt] = lsum[qt] * alpha + ps;
#pragma unroll
                for (int dt = 0; dt < 4; ++dt) ot[dt][qt] = ot[dt][qt] * alpha;
#pragma unroll
                for (int s2 = 0; s2 < 2; ++s2) { v4u w; w.x = pk2(st[2 * s2][q2][0], st[2 * s2][q2][1]); w.y = pk2(st[2 * s2][q2][2], st[2 * s2][q2][3]);
                    w.z = pk2(st[2 * s2 + 1][q2][0], st[2 * s2 + 1][q2][1]); w.w = pk2(st[2 * s2 + 1][q2][2], st[2 * s2 + 1][q2][3]); pf[q2][s2] = as_bf16x8(w); }
            }
#pragma unroll
            for (int dt = 0; dt < 4; ++dt)
#pragma unroll
                for (int s2 = 0; s2 < 2; ++s2) {
                    const v2u lo = *(const LAS v2u*)(VT + (dt * 16 + l15) * AT_PITCH + 32 * s2 + 4 * a4);
                    const v2u hi = *(const LAS v2u*)(VT + (dt * 16 + l15) * AT_PITCH + 32 * s2 + 16 + 4 * a4);
                    v4u w; w.x = lo.x; w.y = lo.y; w.z = hi.x; w.w = hi.y; const bf16x8 va = as_bf16x8(w);
#pragma unroll
                    for (int q2 = 0; q2 < 2; ++q2) ot[dt][2 * qh + q2] = mfma16(va, pf[q2][s2], ot[dt][2 * qh + q2]);
                }
            asm volatile("" ::: "memory");
        }
    }
    const float sk2 = sink[hq] * LOG2E;
#pragma unroll
    for (int qt = 0; qt < 4; ++qt) {
        float l = lsum[qt]; l += __shfl_xor(l, 16); l += __shfl_xor(l, 32);
        l += exp2f(sk2 - mrun[qt]);
        const float inv = 1.f / l;
        bf16* orow = PL + (size_t)(b * T_ + q0w + qt * 16 + l15) * NPL + C_AQ + hq * 64 + 4 * a4;
#pragma unroll
        for (int dt = 0; dt < 4; ++dt) { v2u o; o.x = pk2(ot[dt][qt][0] * inv, ot[dt][qt][1] * inv); o.y = pk2(ot[dt][qt][2] * inv, ot[dt][qt][3] * inv); *(v2u*)(orow + dt * 16) = o; }
    }
}

__device__ __forceinline__ float scan_incl_add(float x, int lane) {
#pragma unroll
    for (int o = 1; o < 64; o <<= 1) { const float y = __shfl_up(x, o); if (lane >= o) x += y; }
    return x;
}
__device__ __forceinline__ float scan_incl_max_up(float x, int lane) {
#pragma unroll
    for (int o = 1; o < 64; o <<= 1) { const float y = __shfl_up(x, o); if (lane >= o) x = fmaxf(x, y); }
    return x;
}
__device__ __forceinline__ float scan_incl_max_down(float x, int lane) {
#pragma unroll
    for (int o = 1; o < 64; o <<= 1) { const float y = __shfl_down(x, o); if (lane + o < 64) x = fmaxf(x, y); }
    return x;
}
__device__ __forceinline__ void gate_cum(float x0, float x1, int dir, int lane, float& b0, float& b1, float& a) {
    const float p = x0 + x1; const float incl = scan_incl_add(p, lane); const float excl = incl - p;
    a = __shfl(incl, 63);
    if (dir == 0) { b0 = excl + x0; b1 = incl; } else { b0 = a - excl; b1 = a - excl - x0; }
}

constexpr int ML_PITCH = 136;
constexpr int ML_KW = 0, ML_VT = 2 * 128 * ML_PITCH * 2, ML_W = ML_VT + 128 * ML_PITCH * 2;
__device__ __forceinline__ void mlstm_summary_item(const Args& A, LAS unsigned char* lds, int item, int tid, int lane, int wave) {
    const int bh = item / NBLK, blk = item % NBLK, b = bh >> 2, h = bh & 3;
    const size_t r0 = blk < 64 ? (size_t)(b * T_ + blk * 128) : (size_t)(MLAT + b * CTXL + (blk - 64) * 128);
    const bf16* PL = (const bf16*)(A.ws + WS_PL);
    const float* GATE = (const float*)(A.ws + WS_GATE);
    float* SCA = (float*)(A.ws + WS_SC); float* NS = (float*)(A.ws + WS_NS);
    bf16* CT = (bf16*)(A.ws + WS_XN);
    LAS bf16* KW = (LAS bf16*)(lds + ML_KW); LAS bf16* VT = (LAS bf16*)(lds + ML_VT); LAS float* WL = (LAS float*)(lds + ML_W);
    const int l15 = lane & 15, a4 = lane >> 4;
    __syncthreads();
    if (wave < 2) {
        const int dir = wave, s0 = 2 * lane;
        const float* gp = GATE + (r0 + s0) * 16 + dir * 8 + h;
        const float li0 = gp[0], lf0 = gp[4], li1 = gp[16], lf1 = gp[16 + 4];
        float b0, b1, a; gate_cum(lf0, lf1, dir, lane, b0, b1, a);
        const float wl0 = a - b0 + li0, wl1 = a - b1 + li1;
        const float mloc = wave_max(fmaxf(wl0, wl1));
        WL[dir * 128 + s0] = __expf(wl0 - mloc); WL[dir * 128 + s0 + 1] = __expf(wl1 - mloc);
        if (lane == 0) { const int seq = bh * 2 + dir; SCA[seq * NBLK + blk] = a; SCA[16 * NBLK + seq * NBLK + blk] = mloc; }
    }
    __syncthreads();
    {
        const int s = tid >> 2, c4 = tid & 3;
        const float w0 = WL[s], w1 = WL[128 + s];
        const bf16* kp = PL + (r0 + s) * NPL + C_KM + h * 128 + 32 * c4;
        const bf16* vp = PL + (r0 + s) * NPL + C_VM + h * 128 + 32 * c4;
#pragma unroll
        for (int q = 0; q < 4; ++q) {
            const v4u kr = *(const v4u*)(kp + 8 * q); const v4u vr = *(const v4u*)(vp + 8 * q);
            const unsigned kw_[4] = {kr.x, kr.y, kr.z, kr.w}; const unsigned vw_[4] = {vr.x, vr.y, vr.z, vr.w};
#pragma unroll
            for (int e = 0; e < 4; ++e) {
                const int d0 = 32 * c4 + 8 * q + 2 * e;
                const float k0 = bflo(kw_[e]), k1 = bfhi(kw_[e]);
                ((LAS u16*)KW)[(d0) * ML_PITCH + s] = (u16)f2bf(k0 * w0); ((LAS u16*)KW)[(d0 + 1) * ML_PITCH + s] = (u16)f2bf(k1 * w0);
                ((LAS u16*)KW)[(128 + d0) * ML_PITCH + s] = (u16)f2bf(k0 * w1); ((LAS u16*)KW)[(128 + d0 + 1) * ML_PITCH + s] = (u16)f2bf(k1 * w1);
                ((LAS u16*)VT)[(d0) * ML_PITCH + s] = (u16)(vw_[e] & 0xffffu); ((LAS u16*)VT)[(d0 + 1) * ML_PITCH + s] = (u16)(vw_[e] >> 16);
            }
        }
    }
    __syncthreads();
    if (tid < 256) {
        const LAS bf16* rowp = KW + tid * ML_PITCH; float acc = 0.f;
#pragma unroll 4
        for (int q = 0; q < 16; ++q) { const v4u w = *(const LAS v4u*)(rowp + 8 * q); acc += (bflo(w.x) + bfhi(w.x)) + (bflo(w.y) + bfhi(w.y)) + (bflo(w.z) + bfhi(w.z)) + (bflo(w.w) + bfhi(w.w)); }
        const int dir = tid >> 7, dk = tid & 127; NS[((size_t)(bh * 2 + dir) * NBLK + blk) * 128 + dk] = acc;
    }
    {
        const int dir = wave >> 2, dkt0 = 2 * (wave & 3);
        f32x4 acc[2][8];
#pragma unroll
        for (int i = 0; i < 2; ++i)
#pragma unroll
            for (int j = 0; j < 8; ++j) acc[i][j] = (f32x4){0.f, 0.f, 0.f, 0.f};
#pragma unroll
        for (int ks = 0; ks < 4; ++ks) {
            bf16x8 af[2];
#pragma unroll
            for (int i = 0; i < 2; ++i) af[i] = *(const LAS bf16x8*)(KW + (dir * 128 + (dkt0 + i) * 16 + l15) * ML_PITCH + 32 * ks + 8 * a4);
#pragma unroll
            for (int j = 0; j < 8; ++j) { const bf16x8 bfr = *(const LAS bf16x8*)(VT + (j * 16 + l15) * ML_PITCH + 32 * ks + 8 * a4);
#pragma unroll
                for (int i = 0; i < 2; ++i) acc[i][j] = mfma16(af[i], bfr, acc[i][j]); }
        }
        bf16* ctp = CT + ((size_t)(bh * 2 + dir) * NBLK + blk) * 16384;
#pragma unroll
        for (int i = 0; i < 2; ++i)
#pragma unroll
            for (int j = 0; j < 8; ++j) { v2u o; o.x = pk2(acc[i][j][0], acc[i][j][1]); o.y = pk2(acc[i][j][2], acc[i][j][3]);
                *(v2u*)(ctp + (size_t)(j * 16 + l15) * 128 + (dkt0 + i) * 16 + 4 * a4) = o; }
    }
}

__device__ __forceinline__ int scan_blk(int dir, int step) { return dir == 0 ? (step < 2 ? 64 + step : step - 2) : (step < 2 ? 65 - step : 65 - step); }
__device__ __forceinline__ void p4_scan(const Args& A, int tid, int vcu, int G) {
    const int gid = vcu * NTHR + tid;
    if (gid >= 16 * 8192) return;
    const int seq = gid >> 13, e = gid & 8191, dir = seq & 1;
    float* SCA = (float*)(A.ws + WS_SC); const float* AC = SCA + seq * NBLK; const float* MC = SCA + 16 * NBLK + seq * NBLK; float* MS = SCA + 32 * NBLK + seq * NBLK;
    unsigned* CT = (unsigned*)(A.ws + WS_XN) + (size_t)seq * NBLK * 8192 + e;
    float* NS = (float*)(A.ws + WS_NS) + (size_t)seq * NBLK * 128 + e;
    float c0 = 0.f, c1 = 0.f, nn = 0.f, m = 0.f;
    for (int base = 0; base < 66; base += 11) {
        unsigned ld[11]; float ac[11], mc[11], nl[11];
#pragma unroll
        for (int j = 0; j < 11; ++j) { const int blk = scan_blk(dir, base + j); ld[j] = CT[(size_t)blk * 8192]; ac[j] = AC[blk]; mc[j] = MC[blk]; nl[j] = e < 128 ? NS[blk * 128] : 0.f; }
#pragma unroll
        for (int j = 0; j < 11; ++j) {
            const int step = base + j, blk = scan_blk(dir, step);
            if (step >= 2) { CT[(size_t)blk * 8192] = pk2(c0, c1); if (e < 128) NS[blk * 128] = nn; if (e == 0) MS[blk] = m; }
            const float mnew = fmaxf(ac[j] + m, mc[j]);
            const float dold = __expf(ac[j] + m - mnew), dnew = __expf(mc[j] - mnew);
            c0 = dold * c0 + dnew * bflo(ld[j]); c1 = dold * c1 + dnew * bfhi(ld[j]); nn = dold * nn + dnew * nl[j]; m = mnew;
        }
    }
}

constexpr int MO_VT = 0, MO_G = 128 * ML_PITCH * 2;
__device__ __forceinline__ void mlstm_out_item(const Args& A, LAS unsigned char* lds, int item, int tid, int lane, int wave) {
    const int bh = item >> 6, blk = item & 63, b = bh >> 2, h = bh & 3;
    const size_t r0 = (size_t)(b * T_ + blk * 128);
    bf16* PL = (bf16*)(A.ws + WS_PL);
    const float* GATE = (const float*)(A.ws + WS_GATE);
    const float* SCA = (const float*)(A.ws + WS_SC); const float* NS = (const float*)(A.ws + WS_NS);
    const bf16* CT = (const bf16*)(A.ws + WS_XN);
    const float* mng = A.in[10];
    LAS bf16* VT = (LAS bf16*)(lds + MO_VT); LAS float* GE = (LAS float*)(lds + MO_G); LAS float* GM = GE + 256; LAS float* GB = GE + 512;
    const int l15 = lane & 15, a4 = lane >> 4;
    __syncthreads();
    if (wave < 2) {
        const int dir = wave, s0 = 2 * lane, seq = bh * 2 + dir;
        const float* gp = GATE + (r0 + s0) * 16 + dir * 8 + h;
        const float li0 = gp[0], lf0 = gp[4], li1 = gp[16], lf1 = gp[16 + 4];
        float b0, b1, a; gate_cum(lf0, lf1, dir, lane, b0, b1, a);
        const float e0 = li0 - b0, e1 = li1 - b1;
        const float ms0 = SCA[32 * NBLK + seq * NBLK + blk];
        float M0, M1;
        if (dir == 0) { const float inc = scan_incl_max_up(fmaxf(e0, e1), lane); float exc = __shfl_up(inc, 1); if (lane == 0) exc = -INFINITY; M0 = fmaxf(exc, e0); M1 = inc; }
        else { const float inc = scan_incl_max_down(fmaxf(e0, e1), lane); float exc = __shfl_down(inc, 1); if (lane == 63) exc = -INFINITY; M1 = fmaxf(exc, e1); M0 = inc; }
        M0 = fmaxf(M0, ms0); M1 = fmaxf(M1, ms0);
        GE[dir * 128 + s0] = e0; GE[dir * 128 + s0 + 1] = e1; GM[dir * 128 + s0] = M0; GM[dir * 128 + s0 + 1] = M1; GB[dir * 128 + s0] = b0; GB[dir * 128 + s0 + 1] = b1;
    }
    {
        const int s = tid >> 2, c4 = tid & 3;
        const bf16* vp = PL + (r0 + s) * NPL + C_VM + h * 128 + 32 * c4;
#pragma unroll
        for (int q = 0; q < 4; ++q) { const v4u vr = *(const v4u*)(vp + 8 * q); const unsigned vw_[4] = {vr.x, vr.y, vr.z, vr.w};
#pragma unroll
            for (int e = 0; e < 4; ++e) { const int d0 = 32 * c4 + 8 * q + 2 * e; ((LAS u16*)VT)[(d0) * ML_PITCH + s] = (u16)(vw_[e] & 0xffffu); ((LAS u16*)VT)[(d0 + 1) * ML_PITCH + s] = (u16)(vw_[e] >> 16); } }
    }
    __syncthreads();
    const int tq = 16 * wave + l15;
    bf16x8 qf[4];
#pragma unroll
    for (int ks = 0; ks < 4; ++ks) qf[ks] = as_bf16x8(*(const v4u*)(PL + (r0 + tq) * NPL + C_QM + h * 128 + 32 * ks + 8 * a4));
    f32x4 sT[8];
#pragma unroll
    for (int st = 0; st < 8; ++st) { f32x4 z = (f32x4){0.f, 0.f, 0.f, 0.f};
#pragma unroll
        for (int ks = 0; ks < 4; ++ks) { const bf16x8 kf = as_bf16x8(*(const v4u*)(PL + (r0 + st * 16 + l15) * NPL + C_KM + h * 128 + 32 * ks + 8 * a4)); z = mfma16(kf, qf[ks], z); }
        sT[st] = z; }
    f32x4 hout[8];
#pragma unroll
    for (int j = 0; j < 8; ++j) hout[j] = (f32x4){0.f, 0.f, 0.f, 0.f};
#pragma unroll 1
    for (int dir = 0; dir < 2; ++dir) {
        const int seq = bh * 2 + dir;
        const float Mt = GM[dir * 128 + tq], bt = GB[dir * 128 + tq];
        const float ms0 = SCA[32 * NBLK + seq * NBLK + blk];
        const float inter = __expf(ms0 - Mt);
        bf16x8 pf[4]; float dsum = 0.f;
#pragma unroll
        for (int ks2 = 0; ks2 < 4; ++ks2) { float p[8];
#pragma unroll
            for (int j = 0; j < 8; ++j) { const int st = 2 * ks2 + (j >> 2), i = j & 3, s = 16 * st + 4 * a4 + i;
                const bool on = dir == 0 ? (s <= tq) : (s >= tq);
                const float dv = on ? __expf(GE[dir * 128 + s] - Mt) : 0.f;
                p[j] = sT[st][i] * dv; dsum += p[j]; }
            v4u w; w.x = pk2(p[0], p[1]); w.y = pk2(p[2], p[3]); w.z = pk2(p[4], p[5]); w.w = pk2(p[6], p[7]); pf[ks2] = as_bf16x8(w); }
        dsum += __shfl_xor(dsum, 16); dsum += __shfl_xor(dsum, 32);
        float qn;
        { f32x4 z = (f32x4){0.f, 0.f, 0.f, 0.f}; const float* np = NS + ((size_t)seq * NBLK + blk) * 128;
#pragma unroll
          for (int ks = 0; ks < 4; ++ks) { v4u w = (v4u){0u, 0u, 0u, 0u};
              if (l15 == 0) { const f32x4 n0 = *(const f32x4*)(np + 32 * ks + 8 * a4), n1 = *(const f32x4*)(np + 32 * ks + 8 * a4 + 4); w.x = pk2(n0.x, n0.y); w.y = pk2(n0.z, n0.w); w.z = pk2(n1.x, n1.y); w.w = pk2(n1.z, n1.w); }
              z = mfma16(as_bf16x8(w), qf[ks], z); }
          qn = __shfl(z[0], l15); }
        const float den = dsum + inter * qn;
        const float dn = fmaxf(fabsf(den), __expf(-(bt + Mt)));
        const float rden = 1.f / dn;
        const bf16* ctp = CT + ((size_t)seq * NBLK + blk) * 16384;
#pragma unroll
        for (int dvt = 0; dvt < 8; ++dvt) {
            f32x4 nz = (f32x4){0.f, 0.f, 0.f, 0.f}, cz = (f32x4){0.f, 0.f, 0.f, 0.f};
#pragma unroll
            for (int ks2 = 0; ks2 < 4; ++ks2) {
                const v2u lo = *(const LAS v2u*)(VT + (dvt * 16 + l15) * ML_PITCH + 32 * ks2 + 4 * a4);
                const v2u hi = *(const LAS v2u*)(VT + (dvt * 16 + l15) * ML_PITCH + 32 * ks2 + 16 + 4 * a4);
                v4u w; w.x = lo.x; w.y = lo.y; w.z = hi.x; w.w = hi.y;
                nz = mfma16(as_bf16x8(w), pf[ks2], nz);
            }
#pragma unroll
            for (int ks = 0; ks < 4; ++ks) { const bf16x8 cf = as_bf16x8(*(const v4u*)(ctp + (size_t)(dvt * 16 + l15) * 128 + 32 * ks + 8 * a4)); cz = mfma16(cf, qf[ks], cz); }
            hout[dvt] = hout[dvt] + (nz + cz * inter) * rden;
            asm volatile("" ::: "memory");
        }
    }
    float ss = 0.f;
#pragma unroll
    for (int j = 0; j < 8; ++j) ss += (hout[j][0] * hout[j][0] + hout[j][1] * hout[j][1]) + (hout[j][2] * hout[j][2] + hout[j][3] * hout[j][3]);
    ss += __shfl_xor(ss, 16); ss += __shfl_xor(ss, 32);
    const float rstd = rsqrtf(ss * (1.f / 128.f) + EPS);
#pragma unroll
    for (int j = 0; j < 8; ++j) { const int dv = 16 * j + 4 * a4;
        const f32x4 gv = *(const f32x4*)(mng + h * 128 + dv);
        const v2u ow = *(const v2u*)(PL + (r0 + tq) * NPL + C_OM + h * 128 + dv);
        v2u o; o.x = pk2(hout[j][0] * rstd * gv.x * bflo(ow.x), hout[j][1] * rstd * gv.y * bfhi(ow.x)); o.y = pk2(hout[j][2] * rstd * gv.z * bflo(ow.y), hout[j][3] * rstd * gv.w * bfhi(ow.y));
        *(v2u*)(PL + (r0 + tq) * NPL + C_QM + h * 128 + dv) = o; }
}

__device__ __forceinline__ void p8_prenorm2(const Args& A, int tid, int lane, int wave, int vcu, int G) {
    unsigned char* ws = A.ws;
    const float* x1 = A.out; const float* ng = A.in[7];
    const float* MOD = (const float*)(ws + WS_MOD);
    bf16* H2 = (bf16*)(ws + WS_XN);
    const int gw = vcu * NWAVES + wave, NGW = G * NWAVES;
    for (int r = gw; r < MLAT; r += NGW) {
        const float* src = x1 + (size_t)r * DM; const float* mrow = MOD + (r / T_) * 6144;
        f32x4 v[4]; float ss = 0.f;
#pragma unroll
        for (int j = 0; j < 4; ++j) { v[j] = *(const f32x4*)(src + 4 * lane + 256 * j); ss += (v[j].x * v[j].x + v[j].y * v[j].y) + (v[j].z * v[j].z + v[j].w * v[j].w); }
        const float rstd = rsqrtf(wave_sum(ss) * (1.f / DM) + EPS);
#pragma unroll
        for (int j = 0; j < 4; ++j) { const int c = 4 * lane + 256 * j;
            const f32x4 g = *(const f32x4*)(ng + c), sh = *(const f32x4*)(mrow + 3 * 1024 + c), sc = *(const f32x4*)(mrow + 4 * 1024 + c);
            v2u o; o.x = pk2(v[j].x * rstd * g.x * (1.f + sc.x) + sh.x, v[j].y * rstd * g.y * (1.f + sc.y) + sh.y);
            o.y = pk2(v[j].z * rstd * g.z * (1.f + sc.z) + sh.z, v[j].w * rstd * g.w * (1.f + sc.w) + sh.w);
            *(v2u*)(H2 + (size_t)r * DM + c) = o; }
    }
    const int gt = vcu * NTHR + tid, NGT = G * NTHR;
    const float* pu = A.in[19]; const float* pv = A.in[20]; bf16* U16 = (bf16*)(ws + WS_U16); bf16* V16 = (bf16*)(ws + WS_V16);
    for (int i = gt; i < 16384 * 1024 / 8; i += NGT) {
        const f32x4 a0 = *(const f32x4*)(pu + 8 * (size_t)i), a1 = *(const f32x4*)(pu + 8 * (size_t)i + 4);
        const f32x4 b0 = *(const f32x4*)(pv + 8 * (size_t)i), b1 = *(const f32x4*)(pv + 8 * (size_t)i + 4);
        v4u o; o.x = pk2(a0.x, a0.y); o.y = pk2(a0.z, a0.w); o.z = pk2(a1.x, a1.y); o.w = pk2(a1.z, a1.w); *(v4u*)(U16 + 8 * (size_t)i) = o;
        v4u p; p.x = pk2(b0.x, b0.y); p.y = pk2(b0.z, b0.w); p.z = pk2(b1.x, b1.y); p.w = pk2(b1.z, b1.w); *(v4u*)(V16 + 8 * (size_t)i) = p;
    }
}

constexpr int RT_SC = 0, RT_PITCH = 129;
constexpr int RT_IDX = 256 * RT_PITCH * 4;
constexpr int RT_GT = RT_IDX + 32 * 128 * 2;
constexpr int RT_WT = RT_GT + 32 * 128 * 4;
static_assert(RT_WT + 8 * 128 * 4 <= MISC_OFF, "routing LDS map");
__device__ __forceinline__ void peer_item(const Args& A, LAS unsigned char* lds, int item, int tid, int lane, int wave) {
    unsigned char* ws = A.ws;
    const int tok0 = item * 32;
    const bf16* Q = (const bf16*)(ws + WS_Q); const bf16* SK = (const bf16*)(ws + WS_SK);
    const bf16* H2 = (const bf16*)(ws + WS_XN); const bf16* U16 = (const bf16*)(ws + WS_U16); const bf16* V16 = (const bf16*)(ws + WS_V16);
    const float* MOD = (const float*)(ws + WS_MOD);
    LAS float* SC = (LAS float*)(lds + RT_SC); LAS u16* IDXL = (LAS u16*)(lds + RT_IDX); LAS float* GTL = (LAS float*)(lds + RT_GT); LAS float* WTS = (LAS float*)(lds + RT_WT) + wave * 128;
    const int l15 = lane & 15, a4 = lane >> 4;
    for (int hi = 0; hi < 2; ++hi) {
        __syncthreads();
        {
            const int hl = wave >> 1, p = wave & 1, h = 4 * hi + hl;
            f32x4 acc[2][8];
#pragma unroll
            for (int i = 0; i < 2; ++i)
#pragma unroll
                for (int j = 0; j < 8; ++j) acc[i][j] = (f32x4){0.f, 0.f, 0.f, 0.f};
            const bf16* qp = Q + (size_t)(tok0 + l15) * 2048 + h * 256 + p * 128 + 8 * a4;
            const bf16* kp = SK + ((size_t)(h * 2 + p) * 128 + l15) * 128 + 8 * a4;
#pragma unroll
            for (int ks = 0; ks < 4; ++ks) {
                bf16x8 af[2];
#pragma unroll
                for (int i = 0; i < 2; ++i) af[i] = as_bf16x8(*(const v4u*)(qp + (size_t)i * 16 * 2048 + 32 * ks));
#pragma unroll
                for (int j = 0; j < 8; ++j) { const bf16x8 bfr = as_bf16x8(*(const v4u*)(kp + (size_t)j * 16 * 128 + 32 * ks));
#pragma unroll
                    for (int i = 0; i < 2; ++i) acc[i][j] = mfma16(af[i], bfr, acc[i][j]); }
            }
#pragma unroll
            for (int i = 0; i < 2; ++i)
#pragma unroll
                for (int j = 0; j < 8; ++j)
#pragma unroll
                    for (int e = 0; e < 4; ++e) { const int tl = i * 16 + 4 * a4 + e; SC[((tl * 4 + hl) * 2 + p) * RT_PITCH + j * 16 + l15] = acc[i][j][e]; }
        }
        __syncthreads();
        if (tid < 256) {
            LAS float* rowp = SC + tid * RT_PITCH;
            float sv[16]; int si[16];
#pragma unroll
            for (int k = 0; k < 16; ++k) {
                float best = -INFINITY; int bi = 0;
                for (int j = 0; j < 128; ++j) { const float v = rowp[j]; if (v > best) { best = v; bi = j; } }
                rowp[bi] = -INFINITY; sv[k] = best; si[k] = bi;
            }
#pragma unroll
            for (int k = 0; k < 16; ++k) { rowp[k] = sv[k]; rowp[16 + k] = __builtin_bit_cast(float, si[k]); }
        }
        __syncthreads();
        if (tid < 128) {
            const int tl = tid >> 2, hl = tid & 3, h = 4 * hi + hl;
            const LAS float* r1 = SC + ((tl * 4 + hl) * 2) * RT_PITCH; const LAS float* r2 = r1 + RT_PITCH;
            float s1[16], s2[16]; int i1[16], i2[16];
#pragma unroll
            for (int k = 0; k < 16; ++k) { s1[k] = r1[k]; i1[k] = __builtin_bit_cast(int, r1[16 + k]); s2[k] = r2[k]; i2[k] = __builtin_bit_cast(int, r2[16 + k]); }
            float pv = INFINITY; int ppos = -1;
#pragma unroll 1
            for (int k = 0; k < 16; ++k) {
                float bv = -INFINITY; int bpos = 1 << 20, bidx = 0;
#pragma unroll
                for (int i = 0; i < 16; ++i)
#pragma unroll
                    for (int j = 0; j < 16; ++j) if ((i + 1) * (j + 1) <= 16) {
                        const float v = s1[i] + s2[j]; const int pos = i * 16 + j;
                        const bool elig = (v < pv) || (v == pv && pos > ppos);
                        if (elig && v > bv) { bv = v; bpos = pos; bidx = i1[i] * 128 + i2[j]; }
                    }
                IDXL[tl * 128 + h * 16 + k] = (u16)bidx; GTL[tl * 128 + h * 16 + k] = bv; pv = bv; ppos = bpos;
            }
            float top[16]; float sum = 0.f;
#pragma unroll
            for (int k = 0; k < 16; ++k) top[k] = GTL[tl * 128 + h * 16 + k];
            const float tmax = top[0];
#pragma unroll
            for (int k = 0; k < 16; ++k) { top[k] = __expf(top[k] - tmax); sum += top[k]; }
            const float rs = 1.f / sum;
#pragma unroll
            for (int k = 0; k < 16; ++k) GTL[tl * 128 + h * 16 + k] = top[k] * rs;
        }
    }
    __syncthreads();
    for (int ti = 0; ti < 4; ++ti) {
        const int tl = wave + 8 * ti; const size_t row = (size_t)(tok0 + tl);
        float xf[16];
        { const v4u r0 = *(const v4u*)(H2 + row * DM + 8 * lane), r1 = *(const v4u*)(H2 + row * DM + 512 + 8 * lane);
          xf[0] = bflo(r0.x); xf[1] = bfhi(r0.x); xf[2] = bflo(r0.y); xf[3] = bfhi(r0.y); xf[4] = bflo(r0.z); xf[5] = bfhi(r0.z); xf[6] = bflo(r0.w); xf[7] = bfhi(r0.w);
          xf[8] = bflo(r1.x); xf[9] = bfhi(r1.x); xf[10] = bflo(r1.y); xf[11] = bfhi(r1.y); xf[12] = bflo(r1.z); xf[13] = bfhi(r1.z); xf[14] = bflo(r1.w); xf[15] = bfhi(r1.w); }
#pragma unroll 4
        for (int e = 0; e < 128; ++e) {
            const int idx = IDXL[tl * 128 + e];
            const bf16* up = U16 + (size_t)idx * DM + 8 * lane;
            const v4u r0 = *(const v4u*)(up), r1 = *(const v4u*)(up + 512);
            float d = xf[0] * bflo(r0.x) + xf[1] * bfhi(r0.x) + xf[2] * bflo(r0.y) + xf[3] * bfhi(r0.y) + xf[4] * bflo(r0.z) + xf[5] * bfhi(r0.z) + xf[6] * bflo(r0.w) + xf[7] * bfhi(r0.w)
                    + xf[8] * bflo(r1.x) + xf[9] * bfhi(r1.x) + xf[10] * bflo(r1.y) + xf[11] * bfhi(r1.y) + xf[12] * bflo(r1.z) + xf[13] * bfhi(r1.z) + xf[14] * bflo(r1.w) + xf[15] * bfhi(r1.w);
            d = wave_sum(d);
            if (lane == 0) WTS[e] = GTL[tl * 128 + e] * gelu_tanh(d);
        }
        LDS_WAIT(); asm volatile("" ::: "memory");
        float acc[16];
#pragma unroll
        for (int i = 0; i < 16; ++i) acc[i] = 0.f;
#pragma unroll 4
        for (int e = 0; e < 128; ++e) {
            const int idx = IDXL[tl * 128 + e]; const float w = WTS[e];
            const bf16* vp = V16 + (size_t)idx * DM + 8 * lane;
            const v4u r0 = *(const v4u*)(vp), r1 = *(const v4u*)(vp + 512);
            acc[0] += w * bflo(r0.x); acc[1] += w * bfhi(r0.x); acc[2] += w * bflo(r0.y); acc[3] += w * bfhi(r0.y); acc[4] += w * bflo(r0.z); acc[5] += w * bfhi(r0.z); acc[6] += w * bflo(r0.w); acc[7] += w * bfhi(r0.w);
            acc[8] += w * bflo(r1.x); acc[9] += w * bfhi(r1.x); acc[10] += w * bflo(r1.y); acc[11] += w * bfhi(r1.y); acc[12] += w * bflo(r1.z); acc[13] += w * bfhi(r1.z); acc[14] += w * bflo(r1.w); acc[15] += w * bfhi(r1.w);
        }
        const float* g2 = MOD + (row / T_) * 6144 + 5 * 1024;
        float* op = A.out + row * DM;
#pragma unroll
        for (int hf = 0; hf < 2; ++hf)
#pragma unroll
            for (int q = 0; q < 2; ++q) { const int c = 512 * hf + 8 * lane + 4 * q;
                const f32x4 xv = *(const f32x4*)(op + c), gv = *(const f32x4*)(g2 + c);
                f32x4 o; o.x = xv.x + gv.x * acc[8 * hf + 4 * q + 0]; o.y = xv.y + gv.y * acc[8 * hf + 4 * q + 1]; o.z = xv.z + gv.z * acc[8 * hf + 4 * q + 2]; o.w = xv.w + gv.w * acc[8 * hf + 4 * q + 3];
                *(f32x4*)(op + c) = o; }
        LDS_WAIT(); asm volatile("" ::: "memory");
    }
}

#ifndef MK_N_LAUNCHES
#define MK_N_LAUNCHES 1
#endif
constexpr int NPH = 11;
__global__ void __launch_bounds__(NTHR, 2) mk_fwd(Args args) {
    extern __shared__ __attribute__((aligned(16))) unsigned char lds_raw[];
    LAS unsigned char* lds = (LAS unsigned char*)lds_raw;
    volatile LAS unsigned* MISC = (volatile LAS unsigned*)(lds + MISC_OFF);
    const int tid = threadIdx.x, lane = tid & 63, wave = __builtin_amdgcn_readfirstlane(tid >> 6);
    const int G = gridDim.x, bx = blockIdx.x;
    const int vcu = (G % 8 == 0) ? (bx % 8) * (G / 8) + bx / 8 : bx;
    for (int u = tid; u < 64; u += NTHR) MISC[u] = 0u;
    __syncthreads();
    const int lo = args.ph_lo, hi = args.ph_hi;
    XcdBarrier bar; bar.bar = (unsigned*)(args.ws + WS_CTL) + CW_BAR; bar.x = 0; bar.st = MISC + 8;
    if (hi - lo > 1) bar = xcd_barrier_post((unsigned*)(args.ws + WS_CTL) + CW_BAR, MISC + 8);
#define IN(k) (lo <= (k) && (k) < hi)
#if defined(ONLY)
#define PH_ON(k) ((k) == ONLY)
#elif defined(SKIP)
#define PH_ON(k) ((k) != SKIP)
#else
#define PH_ON(k) true
#endif
#define SEAM(k) do { if (IN(k) && IN((k) + 1)) xcd_barrier(bar); } while (0)
    unsigned char* ws = args.ws;

    if (IN(0) && PH_ON(0)) { p0_prologue(args, lds, tid, lane, wave, vcu, G); }
    SEAM(0);
    if (IN(1) && PH_ON(1)) { p1_prenorm(args, lds, tid, lane, wave, vcu, G); }
    SEAM(1);
    if (IN(2) && PH_ON(2)) {
        pg8::Gemm g{(const pg8::bf16_t*)(ws + WS_XN), (const pg8::bf16_t*)(ws + WS_WIN), MALL, NPL, DM, DM, DM};
        pg8::StaticOrder S; S.init(MALL, NPL, G, bx);
        EpiPL E{(bf16*)(ws + WS_PL)};
        pg8::gemm_phase<EpiPL, pg8::StaticOrder, true, true>(lds, g, S, E);
    }
    SEAM(2);
    if (IN(3) && PH_ON(3)) {
        for (int u = vcu; u < 256; u += G) attn_unit(args, lds, u, tid, lane, wave);
        for (int it = vcu; it < 8 * NBLK; it += G) mlstm_summary_item(args, lds, it, tid, lane, wave);
    }
    SEAM(3);
    if (IN(4) && PH_ON(4)) { p4_scan(args, tid, vcu, G); }
    SEAM(4);
    if (IN(5) && PH_ON(5)) { for (int it = vcu; it < 512; it += G) mlstm_out_item(args, lds, it, tid, lane, wave); }
    SEAM(5);
    if (IN(6) && PH_ON(6)) {
        __syncthreads();
        {   pg8::Gemm g{(const pg8::bf16_t*)(ws + WS_PL) + C_QM, (const pg8::bf16_t*)(ws + WS_WBM), MLAT, DM, 512, NPL, 512};
            pg8::StaticOrder S; S.init(MLAT, DM, G, bx);
            EpiMerge<0> E{(bf16*)(ws + WS_XN), (const bf16*)(ws + WS_PL) + C_GM};
            pg8::gemm_phase<EpiMerge<0>, pg8::StaticOrder, true, true>(lds, g, S, E); }
        VM_WAIT(); __syncthreads();
        {   pg8::Gemm g{(const pg8::bf16_t*)(ws + WS_PL) + C_AQ, (const pg8::bf16_t*)(ws + WS_WBA), MLAT, DM, 512, NPL, 512};
            pg8::StaticOrder S; S.init(MLAT, DM, G, bx);
            EpiMerge<1> E{(bf16*)(ws + WS_XN), (const bf16*)(ws + WS_PL) + C_GA};
            pg8::gemm_phase<EpiMerge<1>, pg8::StaticOrder, true, true>(lds, g, S, E); }
    }
    SEAM(6);
    if (IN(7) && PH_ON(7)) {
        pg8::Gemm g{(const pg8::bf16_t*)(ws + WS_XN), (const pg8::bf16_t*)(ws + WS_WOUT), MLAT, DM, DM, DM, DM};
        pg8::StaticOrder S; S.init(MLAT, DM, G, bx);
        EpiOut E{args.in[0], args.out, (const float*)(ws + WS_MOD)};
        pg8::gemm_phase<EpiOut, pg8::StaticOrder, true, true>(lds, g, S, E);
    }
    SEAM(7);
    if (IN(8) && PH_ON(8)) { p8_prenorm2(args, tid, lane, wave, vcu, G); }
    SEAM(8);
    if (IN(9) && PH_ON(9)) {
        pg8::Gemm g{(const pg8::bf16_t*)(ws + WS_XN), (const pg8::bf16_t*)(ws + WS_WQ), MLAT, 2048, DM, DM, DM};
        pg8::StaticOrder S; S.init(MLAT, 2048, G, bx);
        EpiQ E{(bf16*)(ws + WS_Q)};
        pg8::gemm_phase<EpiQ, pg8::StaticOrder, true, true>(lds, g, S, E);
    }
    SEAM(9);
    if (IN(10) && PH_ON(10)) { for (int it = vcu; it < MLAT / 32; it += G) peer_item(args, lds, it, tid, lane, wave); }
#undef IN
#undef SEAM
}

extern "C" void kernel_launch(void* const* d_in, const int* in_sizes, int n_in, void* d_out, int out_size, void* d_ws, size_t ws_size, hipStream_t stream) {
    static int grid = 0;
    if (grid == 0) {
        int dev = 0, cus = 0, per_cu = 0;
        if (n_in != 21 || out_size != MLAT * DM || ws_size < WS_END) { fprintf(stderr, "kernel_launch: unexpected shapes (n_in %d out %d ws %zu)\n", n_in, out_size, ws_size); grid = -1; return; }
        if (hipGetDevice(&dev) != hipSuccess || hipDeviceGetAttribute(&cus, hipDeviceAttributeMultiprocessorCount, dev) != hipSuccess) { grid = -1; return; }
        if (hipFuncSetAttribute((const void*)mk_fwd, hipFuncAttributeMaxDynamicSharedMemorySize, LDS_BYTES) != hipSuccess) { fprintf(stderr, "kernel_launch: hipFuncSetAttribute failed\n"); grid = -1; return; }
        if (hipOccupancyMaxActiveBlocksPerMultiprocessor(&per_cu, (const void*)mk_fwd, NTHR, LDS_BYTES) != hipSuccess || per_cu < 1) { fprintf(stderr, "kernel_launch: occupancy query says %d blocks per CU\n", per_cu); (void)hipGetLastError(); per_cu = 1; }
        grid = cus;
        if (grid > 256) grid = 256;
    }
    if (grid < 0) return;
    (void)hipMemsetAsync((char*)d_ws + WS_CTL, 0, CTL_ZERO_BYTES, stream);
    Args a{};
    for (int i = 0; i < 21; ++i) a.in[i] = (const float*)d_in[i];
    a.out = (float*)d_out; a.ws = (unsigned char*)d_ws;
#if MK_N_LAUNCHES == 1
    a.ph_lo = 0; a.ph_hi = NPH;
    void* kargs[] = {&a};
    hipError_t e = hipLaunchCooperativeKernel((const void*)mk_fwd, dim3(grid), dim3(NTHR), kargs, LDS_BYTES, stream);
    if (e != hipSuccess) fprintf(stderr, "kernel_launch: cooperative launch failed: %s (grid %d)\n", hipGetErrorString(e), grid);
#else
    for (int p = 0; p < NPH; ++p) { a.ph_lo = p; a.ph_hi = p + 1; hipLaunchKernelGGL(mk_fwd, dim3(grid), dim3(NTHR), LDS_BYTES, stream, a); }
#endif
}
```
